# Optimizing an MI355X kernel written in HIP

```python
import math
import jax, jax.numpy as jnp
from jax import lax
import numpy as np

D_MODEL = 1024
BATCH = 32
SEQ = 2048
DEPTH = 1

D_MIX = D_MODEL
ATTN_WIDTH = D_MIX // 2
SSM_WIDTH = D_MIX - ATTN_WIDTH
QK_NOPE_DIM = 128
QK_ROPE_DIM = 64
V_HEAD_DIM = 128
N_ATTN_HEADS = ATTN_WIDTH // V_HEAD_DIM
Q_RANK = D_MODEL // 4
KV_RANK = D_MODEL // 8
ROPE_THETA = 10000.0
Q_BLOCK = 128
SSM_GROUP_CH = 16
SSM_GROUPS = SSM_WIDTH // SSM_GROUP_CH
SSM_STATE = 64
DT_MIN = 1e-3
DT_MAX = 1e-1
EPS = 1e-6
SPLITS = (Q_RANK, KV_RANK, QK_ROPE_DIM, ATTN_WIDTH, SSM_WIDTH, SSM_WIDTH)
D_IN = sum(SPLITS)

kernel_name = "hymba_mla_s5_sandwich_encoder"


def _rms_norm(x, g):
    xf = x.astype(jnp.float32)
    y = xf * lax.rsqrt(jnp.mean(xf * xf, axis=-1, keepdims=True) + EPS)
    return (y * g.astype(jnp.float32)).astype(x.dtype)


def _rope_tables(positions, dim):
    inv_freq = ROPE_THETA ** (-jnp.arange(0, dim, 2, dtype=jnp.float32) / dim)
    ang = positions.astype(jnp.float32)[..., None] * inv_freq
    return jnp.cos(ang), jnp.sin(ang)


def _apply_rope(t, cos, sin):
    tf = t.astype(jnp.float32)
    t1, t2 = jnp.split(tf, 2, axis=-1)
    return jnp.concatenate([t1 * cos - t2 * sin, t1 * sin + t2 * cos], axis=-1).astype(t.dtype)


def _mla_attention(z_q, z_kv, z_kr, positions, q_norm_g, w_uq, kv_norm_g, w_ukv):
    bsz, seq, _ = z_q.shape
    q = (_rms_norm(z_q, q_norm_g) @ w_uq).reshape(bsz, seq, N_ATTN_HEADS, QK_NOPE_DIM + QK_ROPE_DIM)
    q_nope, q_rope = q[..., :QK_NOPE_DIM], q[..., QK_NOPE_DIM:]
    kv = (_rms_norm(z_kv, kv_norm_g) @ w_ukv).reshape(bsz, seq, N_ATTN_HEADS, QK_NOPE_DIM + V_HEAD_DIM)
    k_nope, v = kv[..., :QK_NOPE_DIM], kv[..., QK_NOPE_DIM:]
    cos, sin = _rope_tables(positions, QK_ROPE_DIM)
    q_rope = _apply_rope(q_rope, cos[:, :, None, :], sin[:, :, None, :])
    k_rope = _apply_rope(z_kr, cos, sin)
    n_blocks = seq // Q_BLOCK
    scale = (QK_NOPE_DIM + QK_ROPE_DIM) ** -0.5

    def to_blocks(t):
        return t.reshape(bsz, n_blocks, Q_BLOCK, *t.shape[2:]).swapaxes(0, 1)

    def attend_block(args):
        qn, qr = args
        s = (jnp.einsum('bqhd,bkhd->bhqk', qn, k_nope, preferred_element_type=jnp.float32)
             + jnp.einsum('bqhr,bkr->bhqk', qr, k_rope, preferred_element_type=jnp.float32))
        p = jax.nn.softmax(s * scale, axis=-1).astype(v.dtype)
        return jnp.einsum('bhqk,bkhd->bqhd', p, v)

    o = lax.map(attend_block, (to_blocks(q_nope), to_blocks(q_rope)))
    return o.swapaxes(0, 1).reshape(bsz, seq, N_ATTN_HEADS * V_HEAD_DIM)


def _diag_scan_op(e_i, e_j):
    a_i, b_i = e_i
    a_j, b_j = e_j
    return a_j * a_i, a_j * b_i + b_j


def _s5_bidirectional(u, lam_re, lam_im, log_dt, b_re, b_im, c_re, c_im, d_skip):
    bsz, seq, _ = u.shape
    u_t = u.astype(jnp.float32).reshape(bsz, seq, SSM_GROUPS, SSM_GROUP_CH).transpose(1, 0, 2, 3)
    u_c = u_t.astype(jnp.complex64)
    y = jnp.zeros_like(u_t)
    for direction, reverse in ((0, False), (1, True)):
        lam = lax.complex(jnp.minimum(lam_re[direction].astype(jnp.float32), -1e-4),
                          lam_im[direction].astype(jnp.float32))
        dt = jnp.exp(log_dt[direction].astype(jnp.float32))[:, None]
        lam_bar = jnp.exp(lam * dt)
        b = lax.complex(b_re[direction].astype(jnp.float32), b_im[direction].astype(jnp.float32))
        b_bar = ((lam_bar - 1.0) / lam)[..., None] * b
        c = lax.complex(c_re[direction].astype(jnp.float32), c_im[direction].astype(jnp.float32))
        bu = jnp.einsum('sbgh,gph->sbgp', u_c, b_bar)
        a = jnp.broadcast_to(lam_bar, (seq, 1, SSM_GROUPS, SSM_STATE))
        _, h = lax.associative_scan(_diag_scan_op, (a, bu), reverse=reverse, axis=0)
        y = y + jnp.real(jnp.einsum('sbgp,ghp->sbgh', h, c))
    y = y + d_skip.astype(jnp.float32).reshape(SSM_GROUPS, SSM_GROUP_CH) * u_t
    return y.transpose(1, 0, 2, 3).reshape(bsz, seq, SSM_WIDTH).astype(u.dtype)


def setup_inputs(seed: int = 0) -> dict:
    key = jax.random.key(seed)
    ks = jax.random.split(key, 24)
    f32 = jnp.float32
    L, G, P, H = DEPTH, SSM_GROUPS, SSM_STATE, SSM_GROUP_CH

    def nrm(k, shape, std):
        return jax.random.normal(k, shape, f32) * std

    def gain(k, n):
        return 1.0 + 0.05 * jax.random.normal(k, (L, n), f32)

    x = jax.random.normal(ks[0], (BATCH, SEQ, D_MODEL), f32)
    inc = jax.random.randint(ks[1], (BATCH, SEQ), 1, 3, dtype=jnp.int32)
    positions = jnp.cumsum(inc, axis=1, dtype=jnp.int32) - 1
    n_idx = jnp.arange(P, dtype=f32)
    lam_re = -0.5 + 0.01 * jax.random.normal(ks[2], (L, 2, G, P), f32)
    lam_im = math.pi * n_idx + 0.01 * jax.random.normal(ks[3], (L, 2, G, P), f32)
    log_dt = jax.random.uniform(ks[4], (L, 2, G), f32, math.log(DT_MIN), math.log(DT_MAX))
    return {
        "x": x,
        "positions": positions,
        "pre_norm_g": gain(ks[5], D_MODEL),
        "w_in": nrm(ks[6], (L, D_MODEL, D_IN), D_MODEL ** -0.5),
        "q_norm_g": gain(ks[7], Q_RANK),
        "w_uq": nrm(ks[8], (L, Q_RANK, N_ATTN_HEADS * (QK_NOPE_DIM + QK_ROPE_DIM)), Q_RANK ** -0.5),
        "kv_norm_g": gain(ks[9], KV_RANK),
        "w_ukv": nrm(ks[10], (L, KV_RANK, N_ATTN_HEADS * (QK_NOPE_DIM + V_HEAD_DIM)), KV_RANK ** -0.5),
        "attn_out_g": gain(ks[11], ATTN_WIDTH),
        "s5_lam_re": lam_re,
        "s5_lam_im": lam_im,
        "s5_log_dt": log_dt,
        "s5_b_re": nrm(ks[12], (L, 2, G, P, H), (2.0 * H) ** -0.5),
        "s5_b_im": nrm(ks[13], (L, 2, G, P, H), (2.0 * H) ** -0.5),
        "s5_c_re": nrm(ks[14], (L, 2, G, H, P), (2.0 * P) ** -0.5),
        "s5_c_im": nrm(ks[15], (L, 2, G, H, P), (2.0 * P) ** -0.5),
        "s5_d": nrm(ks[16], (L, SSM_WIDTH), 1.0),
        "w_glu": nrm(ks[17], (L, SSM_WIDTH, SSM_WIDTH), SSM_WIDTH ** -0.5),
        "b_glu": nrm(ks[18], (L, SSM_WIDTH), 0.02),
        "ssm_out_g": gain(ks[19], SSM_WIDTH),
        "w_out": nrm(ks[20], (L, D_MIX, D_MODEL), D_MIX ** -0.5),
        "post_norm_g": gain(ks[21], D_MODEL),
    }


def reference(x, positions, pre_norm_g, w_in, q_norm_g, w_uq, kv_norm_g, w_ukv, attn_out_g,
              s5_lam_re, s5_lam_im, s5_log_dt, s5_b_re, s5_b_im, s5_c_re, s5_c_im, s5_d,
              w_glu, b_glu, ssm_out_g, w_out, post_norm_g):
    split_points = list(np.cumsum(SPLITS)[:-1])
    for l in range(DEPTH):
        h = _rms_norm(x, pre_norm_g[l])
        z = h @ w_in[l]
        z_q, z_kv, z_kr, g_attn, u_ssm, g_ssm = jnp.split(z, split_points, axis=-1)
        attn = _mla_attention(z_q, z_kv, z_kr, positions, q_norm_g[l], w_uq[l], kv_norm_g[l], w_ukv[l])
        attn = _rms_norm(attn, attn_out_g[l]) * jax.nn.silu(g_attn)
        ssm = _s5_bidirectional(u_ssm, s5_lam_re[l], s5_lam_im[l], s5_log_dt[l], s5_b_re[l], s5_b_im[l],
                                s5_c_re[l], s5_c_im[l], s5_d[l])
        ssm = jax.nn.gelu(ssm)
        ssm = ssm * jax.nn.sigmoid(ssm @ w_glu[l] + b_glu[l])
        ssm = _rms_norm(ssm, ssm_out_g[l]) * jax.nn.silu(g_ssm)
        mixed = jnp.concatenate([attn, ssm], axis=-1) @ w_out[l]
        x = x + _rms_norm(mixed, post_norm_g[l])
    return x
```

```cpp
#include <hip/hip_runtime.h>
#include <hip/hip_cooperative_groups.h>
#include <stdint.h>
#include <cstdio>

typedef unsigned short bf16_t;
typedef short bf16x8 __attribute__((ext_vector_type(8)));
typedef short s16x4 __attribute__((ext_vector_type(4)));
typedef float f32x16 __attribute__((ext_vector_type(16)));
typedef float f32x4 __attribute__((ext_vector_type(4)));
typedef float f32x2 __attribute__((ext_vector_type(2)));
typedef unsigned u32x4 __attribute__((ext_vector_type(4)));
typedef unsigned u32x2 __attribute__((ext_vector_type(2)));

__device__ __forceinline__ float bf2f(bf16_t v) { return __uint_as_float(((unsigned)v) << 16); }
__device__ __forceinline__ bf16_t f2bf(float f) { unsigned u = __float_as_uint(f); u += 0x7fffu + ((u >> 16) & 1u); return (bf16_t)(u >> 16); }
__device__ __forceinline__ unsigned pack2(float lo, float hi) { unsigned r; asm("v_cvt_pk_bf16_f32 %0, %1, %2" : "=v"(r) : "v"(lo), "v"(hi)); return r; }
__device__ __forceinline__ float sigmoid_f(float v) { return __builtin_amdgcn_rcpf(1.f + __builtin_amdgcn_exp2f(-1.4426950408889634f * v)); }
__device__ __forceinline__ float silu_f(float v) { return v * sigmoid_f(v); }
__device__ __forceinline__ float gelu_tanh_f(float v) {
  const float u2 = 1.5957691216057308f * v * fmaf(0.044715f * v, v, 1.f);
  return v * sigmoid_f(u2);
}

__device__ __forceinline__ int opaque(int x) { asm volatile("" : "+v"(x)); return x; }
constexpr int NB = 32, SEQ = 2048, DM = 1024, NTOK = NB * SEQ;
constexpr int QR = 256, KVR = 128, ROPE = 64, AW = 512, SW = 512, DIN = 1984, DINP = 2048;
constexpr int NH = 4, DQK = 192, DV = 128;
constexpr int SG = 32, SH = 16, SP = 64;
constexpr float EPS = 1e-6f;
constexpr int C_ZQ = 0, C_ZKV = 256, C_ZKR = 384, C_GA = 448, C_US = 960, C_GS = 1472;

constexpr size_t al256(size_t x) { return (x + 255) / 256 * 256; }
constexpr size_t WS_WIN = 0;
constexpr size_t WS_WUQ = WS_WIN + (size_t)DINP * DM * 2;
constexpr size_t WS_WUKV = WS_WUQ + (size_t)768 * 256 * 2;
constexpr size_t WS_WGLU = WS_WUKV + (size_t)1024 * 128 * 2;
constexpr size_t WS_WOUT = WS_WGLU + (size_t)512 * 512 * 2;
constexpr size_t WS_S5P = WS_WOUT + (size_t)1024 * 1024 * 2;
constexpr size_t WS_S5MQ = WS_S5P + (size_t)32 * 256 * 256 * 2;
constexpr size_t WS_S5LT = WS_S5MQ + (size_t)32 * 256 * 512 * 2;
constexpr size_t WS_ROPE = al256(WS_S5LT + (size_t)32 * 2 * 64 * 2 * 4);
constexpr size_t WS_RSX = WS_ROPE + (size_t)NTOK * 64 * 4;
constexpr size_t WS_RSQ = WS_RSX + (size_t)NTOK * 4;
constexpr size_t WS_RSKV = WS_RSQ + (size_t)NTOK * 4;
constexpr size_t WS_GAT = WS_RSKV + (size_t)NTOK * 4;
constexpr size_t WS_GSS = WS_GAT + (size_t)NTOK * 512 * 2;
constexpr size_t WS_US = WS_GSS + (size_t)NTOK * 512 * 2;
constexpr size_t WS_Q = WS_US + (size_t)NTOK * 512 * 2;
constexpr size_t WS_K = WS_Q + (size_t)NTOK * NH * DQK * 2;
constexpr size_t WS_V = WS_K + (size_t)NTOK * NH * DQK * 2;
constexpr size_t WS_XB = WS_V + (size_t)NTOK * NH * DV * 2;
constexpr size_t WS_ZQ = WS_XB + (size_t)NTOK * DM * 2;
constexpr size_t WS_ZKV = WS_ZQ + (size_t)NTOK * 256 * 2;
constexpr size_t WS_O = WS_ZKV + (size_t)NTOK * 128 * 2;
constexpr size_t WS_YS = WS_O + (size_t)NTOK * 512 * 2;
constexpr size_t WS_SCR = WS_YS + (size_t)NTOK * 512 * 2;
constexpr size_t WS_BAR = WS_SCR + (size_t)256 * 393216;
constexpr size_t WS_SSA = WS_BAR + 4096;
constexpr size_t WS_END = WS_SSA + (size_t)NTOK * 16;
constexpr size_t WS_AMIX = WS_XB;
constexpr size_t WS_MIXED = WS_Q;
static_assert(WS_END <= (size_t)1024 * 1024 * 1024, "workspace exceeds 1 GiB");
static_assert((size_t)NTOK * 1024 * 4 <= WS_XB - WS_Q, "mixed alias too large");

struct Params {
  const float* x; const int* pos; const float* pre_g; const float* w_in; const float* q_g; const float* w_uq; const float* kv_g; const float* w_ukv;
  const float* ao_g; const float* lam_re; const float* lam_im; const float* log_dt; const float* b_re; const float* b_im; const float* c_re; const float* c_im;
  const float* s5d; const float* w_glu; const float* b_glu; const float* so_g; const float* w_out; const float* post_g;
  float* out; char* ws;
};
__device__ __forceinline__ void transpose_tile(const float* __restrict__ src, int Nsrc, const float* __restrict__ g0, const float* __restrict__ g1, int gsplit,
                                               bf16_t* __restrict__ dst, int K, int n0, int k0, float* tile, bool tiled = false) {
  const int tid = threadIdx.x;
  const int c = tid & 63, r0 = tid >> 6, n = n0 + c;
  float v[8], gg[8];
#pragma unroll
  for (int i = 0; i < 8; ++i) { const int k = k0 + r0 + 8 * i; v[i] = (n < Nsrc) ? src[(size_t)k * Nsrc + n] : 0.f; gg[i] = g0 ? (k < gsplit ? g0[k] : g1[k - gsplit]) : 1.f; }
#pragma unroll
  for (int i = 0; i < 8; ++i) tile[(r0 + 8 * i) * 65 + c] = v[i] * gg[i];
  __syncthreads();
#pragma unroll
  for (int i = 0; i < 8; ++i) { const int rr = r0 + 8 * i, n = n0 + rr, k = k0 + c;
    const size_t di = tiled ? ((size_t)((n >> 8) * (K >> 5) + (k >> 5)) * 8192 + (size_t)(n & 255) * 32 + (k & 31)) : ((size_t)n * K + k);
    dst[di] = f2bf(tile[c * 65 + rr]); }
  __syncthreads();
}

__device__ void prep_xconv(const Params& p, int slot0, int myslots, int nslot);
__device__ void prep_s5_group(const Params& p, int g, int half, char* lds);
__device__ void prep_phase(const Params& p, int bid, int nblk, float* tile) {
  char* ws = p.ws;
  const int tid = threadIdx.x;
  int wb = bid, nwb = nblk;
  const bool split = (nblk >= 128), s5blk = split && bid < 64;
  if (split) { if (s5blk) { prep_s5_group(p, bid >> 1, bid & 1, (char*)tile); return; } wb = bid - 64; nwb = nblk - 64; }
  else { for (int j = bid; j < 64; j += nblk) prep_s5_group(p, j >> 1, j & 1, (char*)tile); }
  const int T_IN = 32 * 16, T_UQ = 12 * 4, T_UKV = 16 * 2, T_GLU = 8 * 8, T_OUT = 16 * 16;
  const int TT = T_IN + T_UQ + T_UKV + T_GLU + T_OUT;
  for (int j = wb; j < TT; j += nwb) {
    int t = j;
    if (t < T_IN) { transpose_tile(p.w_in, DIN, p.pre_g, p.pre_g, 1 << 30, (bf16_t*)(ws + WS_WIN), DM, (t % 32) * 64, (t / 32) * 64, tile, true); continue; }
    t -= T_IN;
    if (t < T_UQ) { transpose_tile(p.w_uq, 768, p.q_g, p.q_g, 1 << 30, (bf16_t*)(ws + WS_WUQ), 256, (t % 12) * 64, (t / 12) * 64, tile); continue; }
    t -= T_UQ;
    if (t < T_UKV) { transpose_tile(p.w_ukv, 1024, p.kv_g, p.kv_g, 1 << 30, (bf16_t*)(ws + WS_WUKV), 128, (t % 16) * 64, (t / 16) * 64, tile); continue; }
    t -= T_UKV;
    if (t < T_GLU) { transpose_tile(p.w_glu, 512, nullptr, nullptr, 0, (bf16_t*)(ws + WS_WGLU), 512, (t % 8) * 64, (t / 8) * 64, tile); continue; }
    t -= T_GLU;
    transpose_tile(p.w_out, 1024, p.ao_g, p.so_g, 512, (bf16_t*)(ws + WS_WOUT), 1024, (t % 16) * 64, (t / 16) * 64, tile);
  }
  {
    float* rope = (float*)(ws + WS_ROPE);
    const int c = tid & 31;
    const float inv = powf(10000.f, -(float)(2 * c) / 64.f);
    const size_t stride = (size_t)nwb * 512;
    for (size_t i0 = (size_t)wb * 512 + tid; i0 < (size_t)NTOK * 32; i0 += 4 * stride) {
      int ps[4];
#pragma unroll
      for (int u = 0; u < 4; ++u) { const size_t i = i0 + u * stride; ps[u] = (i < (size_t)NTOK * 32) ? p.pos[i >> 5] : 0; }
#pragma unroll
      for (int u = 0; u < 4; ++u) { const size_t i = i0 + u * stride;
        if (i < (size_t)NTOK * 32) { const float ang = (float)ps[u] * inv; const double a = (double)ang, k = rint(a * 0.15915494309189535);
          const float r = (float)(a - k * 6.283185307179586); *(f32x2*)(rope + i * 2) = (f32x2){cosf(r), sinf(r)}; } }
    }
  }
  prep_xconv(p, wb, 1, nwb);
}

__device__ void prep_s5_group(const Params& p, int g, int half, char* lds) {
  f32x2* pw = (f32x2*)lds;
  f32x2* bb = (f32x2*)(lds + 17408);
  float* kt = (float*)(lds + 17408 + 16384);
  f32x2* cc = (f32x2*)(lds + 17408 + 16384 + 32768);
  const int tid = threadIdx.x, nt = blockDim.x;
  f32x2* cf = (f32x2*)(lds + 17408 + 16384 + 32768 + 16384);
  for (int i = tid; i < 128; i += nt) {
    const int dir = i >> 6, pp = i & 63;
    const double lr = (double)fminf(p.lam_re[(dir * SG + g) * SP + pp], -1e-4f), li = (double)p.lam_im[(dir * SG + g) * SP + pp];
    const double dt = exp((double)p.log_dt[dir * SG + g]);
    const double zr = lr * dt, zi = li * dt, er = exp(zr), br_ = er * cos(zi), bi_ = er * sin(zi);
    double wr = 1.0, wi = 0.0;
    for (int t = 0; t <= 16; ++t) { pw[i * 17 + t] = (f32x2){(float)wr, (float)wi}; const double nr = wr * br_ - wi * bi_, ni = wr * bi_ + wi * br_; wr = nr; wi = ni; }
    const double ar = br_ - 1.0, ai = bi_, den = lr * lr + li * li;
    cf[i] = (f32x2){(float)((ar * lr + ai * li) / den), (float)((ai * lr - ar * li) / den)};
  }
  __syncthreads();
  for (int i = tid; i < 128 * 16; i += nt) {
    const int dp = i >> 4, h = i & 15, dir = dp >> 6, pp = dp & 63;
    const f32x2 c = cf[dp];
    const float br = p.b_re[((dir * SG + g) * SP + pp) * SH + h], bi = p.b_im[((dir * SG + g) * SP + pp) * SH + h];
    bb[i] = (f32x2){c[0] * br - c[1] * bi, c[0] * bi + c[1] * br};
  }
  for (int i = tid; i < 2048; i += nt) { const int dir = i >> 10, h = (i >> 6) & 15, pp = i & 63;
    cc[i] = (f32x2){p.c_re[((dir * SG + g) * SH + h) * SP + pp], p.c_im[((dir * SG + g) * SH + h) * SP + pp]}; }
  __syncthreads();
  if (half == 0)
  for (int i = tid; i < 512; i += nt) {
    const int dir = i >> 8, tau = (i >> 4) & 15, h = i & 15;
    float s[16];
#pragma unroll
    for (int h2 = 0; h2 < 16; ++h2) s[h2] = 0.f;
    for (int pp = 0; pp < 64; ++pp) {
      const f32x2 c = cc[(dir * 16 + h) * 64 + pp], w = pw[(dir * 64 + pp) * 17 + tau];
      const float er = c[0] * w[0] - c[1] * w[1], ei = c[0] * w[1] + c[1] * w[0];
#pragma unroll
      for (int h2 = 0; h2 < 16; ++h2) { const f32x2 b = bb[(dir * 64 + pp) * 16 + h2]; s[h2] += er * b[0] - ei * b[1]; }
    }
#pragma unroll
    for (int h2 = 0; h2 < 16; ++h2) kt[i * 16 + h2] = s[h2];
  }
  __syncthreads();
  bf16_t* P = (bf16_t*)(p.ws + WS_S5P) + (size_t)g * 65536;
  if (half == 1)
  for (int i = tid; i < 65536; i += nt) {
    const int n = i >> 8, k = i & 255, dir = n >> 7, pp = (n & 127) >> 1, ri = n & 1, s = k >> 4, h2 = k & 15;
    const f32x2 w = pw[(dir * 64 + pp) * 17 + (dir ? s : 15 - s)], b = bb[(dir * 64 + pp) * 16 + h2];
    P[i] = f2bf(ri ? (w[0] * b[1] + w[1] * b[0]) : (w[0] * b[0] - w[1] * b[1]));
  }
  bf16_t* MQ = (bf16_t*)(p.ws + WS_S5MQ) + (size_t)g * 131072;
  for (int i = tid; i < 131072; i += nt) {
    const int n = i >> 9, k = i & 511, ii = n >> 4, h = n & 15;
    if ((k < 256) != (half == 0)) continue;
    float v;
    if (k < 256) { const int s = k >> 4, h2 = k & 15;
      if (ii > s) v = kt[((0 * 16 + (ii - s)) * 16 + h) * 16 + h2];
      else if (ii < s) v = kt[((1 * 16 + (s - ii)) * 16 + h) * 16 + h2];
      else v = kt[((0 * 16 + 0) * 16 + h) * 16 + h2] + kt[((1 * 16 + 0) * 16 + h) * 16 + h2];
    } else { const int kk = k - 256, dir = kk >> 7, pp = (kk & 127) >> 1, ri = kk & 1;
      const f32x2 c = cc[(dir * 16 + h) * 64 + pp], w = pw[(dir * 64 + pp) * 17 + (dir ? 16 - ii : ii + 1)];
      v = ri ? -(c[0] * w[1] + c[1] * w[0]) : (c[0] * w[0] - c[1] * w[1]);
    }
    MQ[i] = f2bf(v);
  }
  f32x2* LT = (f32x2*)(p.ws + WS_S5LT) + g * 128;
  if (half == 1) for (int i = tid; i < 128; i += nt) LT[i] = pw[i * 17 + 16];
  __syncthreads();
}

__device__ void prep_xconv(const Params& p, int slot0, int myslots, int nslot) {
  char* ws = p.ws;
  const int tid = opaque(threadIdx.x);

    bf16_t* xb = (bf16_t*)(ws + WS_XB); float* rsx = (float*)(ws + WS_RSX);
    const int lane = tid & 63, w = tid >> 6;
#pragma unroll 1
    for (int sl = 0; sl < myslots; ++sl)
#pragma unroll 1
    for (int v0 = ((slot0 + sl) * 8 + w) * 4; v0 < NTOK; v0 += nslot * 8 * 4) {
      const int tv = v0 >> 8, itv = tv >> 5, rest = tv & 31, r0 = ((32 * (rest >> 2) + 4 * (7 - itv) + (rest & 3)) << 8) + (v0 & 255);
      f32x4 v[4][4];
#pragma unroll
      for (int u = 0; u < 4; ++u)
#pragma unroll
        for (int i = 0; i < 4; ++i) v[u][i] = __builtin_nontemporal_load((const f32x4*)(p.x + (size_t)(r0 + u) * DM + i * 256 + lane * 4));
#pragma unroll
      for (int u = 0; u < 4; ++u) {
        float s = 0.f;
#pragma unroll
        for (int i = 0; i < 4; ++i) s += v[u][i][0] * v[u][i][0] + v[u][i][1] * v[u][i][1] + v[u][i][2] * v[u][i][2] + v[u][i][3] * v[u][i][3];
#pragma unroll
        for (int o = 32; o > 0; o >>= 1) s += __shfl_xor(s, o);
        if (lane == 0) rsx[r0 + u] = rsqrtf(s * (1.f / DM) + EPS);
#pragma unroll
        for (int i = 0; i < 4; ++i) { const u32x2 o2 = {pack2(v[u][i][0], v[u][i][1]), pack2(v[u][i][2], v[u][i][3])}; const int row = r0 + u, col = i * 256 + lane * 4;
          *(u32x2*)(xb + (size_t)((row >> 8) * 32 + (col >> 5)) * 8192 + (size_t)(row & 255) * 32 + (col & 31)) = o2; }
      }
    }
}

constexpr int GEMM_LDS = 131072;
#define LDS_BARRIER() do { asm volatile("s_waitcnt lgkmcnt(0)" ::: "memory"); __builtin_amdgcn_s_barrier(); } while (0)
__device__ __forceinline__ int lds_off(int row, int chunk) { return row * 128 + ((chunk ^ ((row >> 1) & 7)) << 4); }

struct GemmRegs { u32x4 ra[4], rb[4]; };
struct GNext { const bf16_t* A; int lda; size_t gs, kts; const bf16_t* B; int ldb; size_t ktsB; int krot, nk; };
__device__ __forceinline__ void gemm256(const bf16_t* __restrict__ A1, int lda1, size_t gs1, size_t ktsA1, int nk1, const bf16_t* __restrict__ A2, int lda2, size_t gs2, size_t ktsA2, int nk2,
                                        const bf16_t* __restrict__ Bt, int ldb, size_t ktsB, char* lds, f32x16 (&acc)[2][4], GemmRegs& G, bool pre, int krot = 0, bool keep_acc = false) {
  const int tid = opaque(threadIdx.x), lane = tid & 63, w = tid >> 6, wm = w >> 2, wn = w & 3, l31 = lane & 31, hi = lane >> 5;
  const int srow = tid >> 3, sch = tid & 7, nk = nk1 + nk2;
  if (!keep_acc) {
#pragma unroll
    for (int nt = 0; nt < 2; ++nt)
#pragma unroll
      for (int mt = 0; mt < 4; ++mt)
#pragma unroll
        for (int r = 0; r < 16; ++r) acc[nt][mt][r] = 0.f;
  }
  const int soff = lds_off(srow, sch);
  const int xoff = (128 * wm + l31) * 128, woff = 32768 + (64 * wn + l31) * 128, swz = (l31 >> 1) & 7;
#define GLOAD(kt) do { const int kq = krot ? (((kt) + krot) & (nk - 1)) : (kt); const bf16_t* Ap; int lda; if (kq < nk1) { Ap = A1 + (size_t)kq * ktsA1 + (sch >> 1) * gs1; lda = lda1; } else { Ap = A2 + (size_t)(kq - nk1) * ktsA2 + (sch >> 1) * gs2; lda = lda2; } \
    _Pragma("unroll") for (int i = 0; i < 4; ++i) G.ra[i] = *(const u32x4*)(Ap + (size_t)(srow + 64 * i) * lda + (sch & 1) * 8); \
    _Pragma("unroll") for (int i = 0; i < 4; ++i) G.rb[i] = *(const u32x4*)(Bt + (size_t)(srow + 64 * i) * ldb + (size_t)kq * ktsB + sch * 8); } while (0)
#define SWRITE(st) do { char* base = lds + (st) * 65536 + soff; \
    _Pragma("unroll") for (int i = 0; i < 4; ++i) { *(u32x4*)(base + 8192 * i) = G.ra[i]; *(u32x4*)(base + 32768 + 8192 * i) = G.rb[i]; } } while (0)
  if (!pre) GLOAD(0);
  SWRITE(0); __syncthreads();
#pragma unroll 1
  for (int kt = 0; kt < nk; ++kt) {
    if (kt + 1 < nk) GLOAD(kt + 1);;
    const char* sb = lds + (kt & 1) * 65536;
#pragma unroll
    for (int ks = 0; ks < 4; ++ks) {
      const int co = ((2 * ks + hi) ^ swz) << 4;
      bf16x8 xf[4], wf[2];
#pragma unroll
      for (int mt = 0; mt < 4; ++mt) xf[mt] = *(const bf16x8*)(sb + xoff + mt * 4096 + co);
#pragma unroll
      for (int nt = 0; nt < 2; ++nt) wf[nt] = *(const bf16x8*)(sb + woff + nt * 4096 + co);
#pragma unroll
      for (int nt = 0; nt < 2; ++nt)
#pragma unroll
        for (int mt = 0; mt < 4; ++mt) acc[nt][mt] = __builtin_amdgcn_mfma_f32_32x32x16_bf16(wf[nt], xf[mt], acc[nt][mt], 0, 0, 0);
    }
    if (kt + 1 < nk) SWRITE((kt + 1) & 1);
    __syncthreads();
  }
#undef GLOAD
#undef SWRITE
}

__device__ __forceinline__ void dma16g(const void* gsrc, unsigned lds_dst) {
  unsigned keep;
  asm volatile("s_mov_b32 %0, m0\n\ts_mov_b32 m0, %2\n\ts_nop 0\n\tglobal_load_lds_dwordx4 %1, off\n\ts_mov_b32 m0, %0" : "=&s"(keep) : "v"(gsrc), "s"(lds_dst) : "memory");
}
__device__ __forceinline__ int sw4(int b) { return (0x78 >> (2 * b)) & 3; }
__device__ __forceinline__ void gemm256_dma(const bf16_t* __restrict__ A1, int lda1, size_t gs1, size_t ktsA1, int nk1, const bf16_t* __restrict__ A2, int lda2, size_t gs2, size_t ktsA2, int nk2,
                                        const bf16_t* __restrict__ Bt, int ldb, size_t ktsB, char* lds, f32x4 (&acc)[4][8], int krot = 0, bool keep_acc = false, const float* resc = nullptr, size_t hsA = 32, size_t hsB = 32) {
  const int tid = opaque(threadIdx.x), lane = tid & 63, w = __builtin_amdgcn_readfirstlane(tid >> 6), wm = w >> 2, wn = w & 3, l15 = lane & 15;
  const int nk = nk1 + nk2, ns = 2 * nk;
  if (!keep_acc) {
#pragma unroll
    for (int nt = 0; nt < 4; ++nt)
#pragma unroll
      for (int mt = 0; mt < 8; ++mt) acc[nt][mt] = (f32x4){0.f, 0.f, 0.f, 0.f};
  }
  const int rb0 = 16 * w + (lane >> 2), rb1 = 16 * (w + 8) + (lane >> 2);
  const int c0 = (lane & 3) ^ sw4((rb0 >> 2) & 3), c1 = (lane & 3) ^ sw4((rb1 >> 2) & 3);
  const unsigned ldsb = (unsigned)(uintptr_t)lds;
#define DMA_SETUP(st_) const int st3_ = (st_), t64_ = st3_ >> 1, hf_ = st3_ & 1, kq_ = krot ? (resc ? ((t64_ & (nk >> 1)) | ((t64_ + krot) & ((nk >> 1) - 1))) : ((t64_ + krot) & (nk - 1))) : t64_; \
    const bf16_t* Ap_; int lda_; size_t gs_; if (kq_ < nk1) { Ap_ = A1 + (size_t)kq_ * ktsA1; lda_ = lda1; gs_ = gs1; } else { Ap_ = A2 + (size_t)(kq_ - nk1) * ktsA2; lda_ = lda2; gs_ = gs2; } \
    const unsigned sb3_ = ldsb + (st3_ & 3) * 32768; const bf16_t* Bp_ = Bt + (size_t)kq_ * ktsB + hf_ * hsB;
#define DMA_PIECE(q) do { if (more) { \
    if ((q) == 0) dma16g(Ap_ + (size_t)rb0 * lda_ + (size_t)hf_ * hsA + (size_t)(c0 >> 1) * gs_ + (c0 & 1) * 8, __builtin_amdgcn_readfirstlane(sb3_ + w * 1024)); \
    if ((q) == 1) dma16g(Ap_ + (size_t)rb1 * lda_ + (size_t)hf_ * hsA + (size_t)(c1 >> 1) * gs_ + (c1 & 1) * 8, __builtin_amdgcn_readfirstlane(sb3_ + (w + 8) * 1024)); \
    if ((q) == 2) dma16g(Bp_ + (size_t)rb0 * ldb + c0 * 8, __builtin_amdgcn_readfirstlane(sb3_ + 16384 + w * 1024)); \
    if ((q) == 3) dma16g(Bp_ + (size_t)rb1 * ldb + c1 * 8, __builtin_amdgcn_readfirstlane(sb3_ + 16384 + (w + 8) * 1024)); } } while (0)
  const int co = (((lane >> 4) ^ sw4(l15 >> 2)) << 4), xoff = (128 * wm + l15) * 64 + co, woff = 16384 + (64 * wn + l15) * 64 + co;
  { const bool more = true; { DMA_SETUP(0) DMA_PIECE(0); DMA_PIECE(1); DMA_PIECE(2); DMA_PIECE(3); } { DMA_SETUP(1) DMA_PIECE(0); DMA_PIECE(1); DMA_PIECE(2); DMA_PIECE(3); } { DMA_SETUP(2) DMA_PIECE(0); DMA_PIECE(1); DMA_PIECE(2); DMA_PIECE(3); } }
#define MMA8(NT) do { _Pragma("unroll") for (int mt = 0; mt < 8; ++mt) acc[NT][mt] = __builtin_amdgcn_mfma_f32_16x16x32_bf16(wf[NT], xf[mt], acc[NT][mt], 0, 0, 0); } while (0)
#pragma unroll 1
  for (int st = 0; st < ns; ++st) {
    if (st + 2 < ns) asm volatile("s_waitcnt vmcnt(8)" ::: "memory"); else if (st + 1 < ns) asm volatile("s_waitcnt vmcnt(4)" ::: "memory"); else asm volatile("s_waitcnt vmcnt(0)" ::: "memory");
    __builtin_amdgcn_s_barrier();
    const bool more = st + 3 < ns;
    DMA_SETUP(st + 3)
    if (resc && st == (ns >> 1)) {
#pragma unroll
      for (int nt = 0; nt < 4; ++nt)
#pragma unroll
        for (int mt = 0; mt < 8; ++mt)
#pragma unroll
          for (int r = 0; r < 4; ++r) acc[nt][mt][r] *= resc[mt];
    }
    const char* sb = lds + (st & 3) * 32768;
    bf16x8 xf[8], wf[4];
    wf[0] = *(const bf16x8*)(sb + woff);
#pragma unroll
    for (int mt = 0; mt < 8; ++mt) xf[mt] = *(const bf16x8*)(sb + xoff + mt * 1024);
#pragma unroll
    for (int nt = 1; nt < 4; ++nt) wf[nt] = *(const bf16x8*)(sb + woff + nt * 1024);
    MMA8(0);
    __builtin_amdgcn_sched_barrier(0); DMA_PIECE(0); __builtin_amdgcn_sched_barrier(0);
    MMA8(1);
    __builtin_amdgcn_sched_barrier(0); DMA_PIECE(1); __builtin_amdgcn_sched_barrier(0);
    MMA8(2);
    __builtin_amdgcn_sched_barrier(0); DMA_PIECE(2); __builtin_amdgcn_sched_barrier(0);
    MMA8(3);
    __builtin_amdgcn_sched_barrier(0); DMA_PIECE(3); __builtin_amdgcn_sched_barrier(0);
    asm volatile("s_waitcnt lgkmcnt(0)" ::: "memory");
  }
#undef DMA_SETUP
#undef DMA_PIECE
#undef MMA8
  __syncthreads();
}

__device__ __forceinline__ void gemm_preload(const GNext nxt, GemmRegs& G) {
  if (!nxt.A) return;
  const int tid = opaque(threadIdx.x), srow = tid >> 3, sch = tid & 7;
  const int kq = nxt.krot ? (nxt.krot & (nxt.nk - 1)) : 0;
  const bf16_t* Ap = nxt.A + (size_t)kq * nxt.kts + (sch >> 1) * nxt.gs;
#pragma unroll
  for (int i = 0; i < 4; ++i) G.ra[i] = *(const u32x4*)(Ap + (size_t)(srow + 64 * i) * nxt.lda + (sch & 1) * 8);
#pragma unroll
  for (int i = 0; i < 4; ++i) G.rb[i] = *(const u32x4*)(nxt.B + (size_t)(srow + 64 * i) * nxt.ldb + (size_t)kq * nxt.ktsB + sch * 8);
}

__device__ __forceinline__ void tile_put(char* lds, int row, int col, unsigned w0, unsigned w1) {
  const u32x2 v = {w0, w1};
  *(u32x2*)(lds + row * 512 + ((((col >> 3) ^ row) & 31) << 4) + ((col & 7) << 1)) = v;
}
__device__ __forceinline__ u32x4 tile_get(const char* lds, int row, int chunk) { return *(const u32x4*)(lds + row * 512 + (((chunk ^ row) & 31) << 4)); }
__device__ __forceinline__ void st16(bf16_t* d, u32x4 v, bool nt) {
  if (nt) __builtin_nontemporal_store(v, (u32x4*)d);
  else *(u32x4*)d = v;
}
__device__ __forceinline__ void tile_out(const char* lds, bf16_t* base, size_t ld, int nrep, size_t rstride, bool wt = false) {
  const int tid = threadIdx.x, chunk = tid & 31, r0 = tid >> 5;
#pragma unroll 1
  for (int hb = 0; hb < 2; ++hb) {
    u32x4 v[8];
#pragma unroll
    for (int i = 0; i < 8; ++i) v[i] = tile_get(lds, r0 + 16 * (8 * hb + i), chunk);
#pragma unroll
    for (int i = 0; i < 8; ++i) {
      bf16_t* d = base + (size_t)(r0 + 16 * (8 * hb + i)) * ld;
      st16(d, v[i], wt);
      if (nrep > 1) { st16(d + rstride, v[i], wt); st16(d + 2 * rstride, v[i], wt); st16(d + 3 * rstride, v[i], wt); }
    }
  }
}
#ifndef WT_STORES
#define WT_STORES 0
#endif
constexpr int LX_RSX = GEMM_LDS, LX_SSQ = GEMM_LDS + 1024  , LX_SSKV = GEMM_LDS + 5120  , LX_END = GEMM_LDS + 7168;

__device__ __forceinline__ int crow(int r, int hi) { return (r & 3) + 8 * (r >> 2) + 4 * hi; }

__device__ void phase1_win(const Params& p, int mtile, int ntile, char* lds, int krot) {
  char* ws = p.ws;
  const int tid = threadIdx.x;
  const int m0 = mtile * 256, bat = m0 / SEQ, s0 = m0 % SEQ;
  float* rsx = (float*)(lds + LX_RSX); float* ssq = (float*)(lds + LX_SSQ); float* sskv = (float*)(lds + LX_SSKV);
  bf16_t* xb = (bf16_t*)(ws + WS_XB); bf16_t* zq = (bf16_t*)(ws + WS_ZQ); bf16_t* zkv = (bf16_t*)(ws + WS_ZKV);
  bf16_t* gat = (bf16_t*)(ws + WS_GAT); bf16_t* gss = (bf16_t*)(ws + WS_GSS); bf16_t* us = (bf16_t*)(ws + WS_US);
  bf16_t* Q = (bf16_t*)(ws + WS_Q); bf16_t* Kf = (bf16_t*)(ws + WS_K); bf16_t* V = (bf16_t*)(ws + WS_V);
  const float* rope = (const float*)(ws + WS_ROPE);
  { const int tp = opaque(tid); if (tp < 256) rsx[tp] = ((const float*)(ws + WS_RSX))[m0 + tp]; }
  __syncthreads();
  f32x4 acc[4][8];
  {
    const int n0 = ntile * 256;
    gemm256_dma(xb + (size_t)mtile * 16 * 16384, 32, 16, 16384, 16, xb, 32, 16, 16384, 0, (const bf16_t*)(ws + WS_WIN) + (size_t)ntile * 16 * 16384, 32, 16384, lds, acc, krot, false, nullptr, 8192, 8192);
    {
      const int tid_o = opaque(threadIdx.x), lane_o = tid_o & 63, l15 = lane_o & 15, q4 = lane_o >> 4, w = tid_o >> 6, wm = w >> 2, wn = w & 3;
      const int cb = n0 + 64 * wn;
      if (cb == C_ZKR) {
#pragma unroll
        for (int mt = 0; mt < 8; ++mt) {
          const int rl = 128 * wm + 16 * mt + l15;
          const float rs = rsx[rl];
          const float* rp = rope + ((size_t)(m0 + rl) * 32 + 4 * q4) * 2;
#pragma unroll
          for (int nt = 0; nt < 2; ++nt) {
            const f32x4 t0 = *(const f32x4*)(rp + 32 * nt), t1 = *(const f32x4*)(rp + 32 * nt + 4);
            const float cs[4] = {t0[0], t0[2], t1[0], t1[2]}, sn[4] = {t0[1], t0[3], t1[1], t1[3]};
            float o1[4], o2[4];
#pragma unroll
            for (int e = 0; e < 4; ++e) { const float a = acc[nt][mt][e] * rs, bb = acc[nt + 2][mt][e] * rs; o1[e] = a * cs[e] - bb * sn[e]; o2[e] = a * sn[e] + bb * cs[e]; }
            tile_put(lds, rl, 64 * wn + 16 * nt + 4 * q4, pack2(o1[0], o1[1]), pack2(o1[2], o1[3]));
            tile_put(lds, rl, 64 * wn + 32 + 16 * nt + 4 * q4, pack2(o2[0], o2[1]), pack2(o2[2], o2[3]));
          }
          if (mt & 1) __builtin_amdgcn_sched_barrier(0);
        }
      } else if (cb < C_ZKR) {
#pragma unroll
        for (int mt = 0; mt < 8; ++mt) {
          const int rl = 128 * wm + 16 * mt + l15;
          const float rs = rsx[rl];
          float sq = 0.f;
#pragma unroll
          for (int nt = 0; nt < 4; ++nt) {
            float v[4];
#pragma unroll
            for (int e = 0; e < 4; ++e) { v[e] = acc[nt][mt][e] * rs; sq += v[e] * v[e]; }
            tile_put(lds, rl, 64 * wn + 16 * nt + 4 * q4, pack2(v[0], v[1]), pack2(v[2], v[3]));
          }
          sq += __shfl_xor(sq, 16); sq += __shfl_xor(sq, 32);
          if (q4 == 0) { if (cb < C_ZKV) ssq[wn * 256 + rl] = sq; else sskv[wn * 256 + rl] = sq; }
          if (mt & 1) __builtin_amdgcn_sched_barrier(0);
        }
      } else if (cb < DIN) {
        const bool gate = !(cb >= C_US && cb < C_GS);
#pragma unroll
        for (int mt = 0; mt < 8; ++mt) {
          const int rl = 128 * wm + 16 * mt + l15;
          const float rs = rsx[rl];
#pragma unroll
          for (int nt = 0; nt < 4; ++nt) {
            float v[4];
#pragma unroll
            for (int e = 0; e < 4; ++e) { v[e] = acc[nt][mt][e] * rs; if (gate) v[e] = silu_f(v[e]); }
            tile_put(lds, rl, 64 * wn + 16 * nt + 4 * q4, pack2(v[0], v[1]), pack2(v[2], v[3]));
          }
          if (mt & 1) __builtin_amdgcn_sched_barrier(0);
        }
      }
    }
    __syncthreads();
    {
      const int col = n0 + (opaque(tid) & 31) * 8;
      bf16_t* base = nullptr; size_t ld = 0; int nrep = 1;
      if (col < C_ZKV) { base = zq + (size_t)m0 * 256 + col; ld = 256; }
      else if (col < C_ZKR) { base = zkv + (size_t)m0 * 128 + (col - C_ZKV); ld = 128; }
      else if (col < C_GA) { base = Kf + (((size_t)bat * NH) * SEQ + s0) * DQK + 128 + (col - C_ZKR); ld = DQK; nrep = 4; }
      else if (col < C_US) { base = gat + (size_t)m0 * 512 + (col - C_GA); ld = 512; }
      else if (col < C_GS) { const int cc = col - C_US; base = us + ((size_t)(cc >> 4) * NTOK + m0) * 16 + (cc & 15); ld = 16; }
      else if (col < DIN) { base = gss + (size_t)m0 * 512 + (col - C_GS); ld = 512; }
      if (base) tile_out(lds, base, ld, nrep, (size_t)SEQ * DQK, (col >= C_GA && col < C_US) || col >= C_GS);
    }
    __syncthreads();
  }
}

__device__ void phase1_up(const Params& p, int mtile, int which, char* lds, bool partials) {
  GemmRegs G;
  char* ws = p.ws;
  const int tid = threadIdx.x, lane = tid & 63, w = tid >> 6, wm = w >> 2, wn = w & 3;
  const int m0 = mtile * 256, bat = m0 / SEQ, s0 = m0 % SEQ;
  float* ssqp = (float*)(lds + LX_SSQ); float* sskp = (float*)(lds + LX_SSKV); float* ssq = (float*)(lds + LX_END); float* sskv = (float*)(lds + LX_END + 1024);
  bf16_t* zq = (bf16_t*)(ws + WS_ZQ); bf16_t* zkv = (bf16_t*)(ws + WS_ZKV);
  bf16_t* Q = (bf16_t*)(ws + WS_Q); bf16_t* Kf = (bf16_t*)(ws + WS_K); bf16_t* V = (bf16_t*)(ws + WS_V);
  const float* rope = (const float*)(ws + WS_ROPE);
  if (partials) { const int tp = opaque(tid); if (tp < 256) { ssq[tp] = ssqp[tp] + ssqp[256 + tp] + ssqp[512 + tp] + ssqp[768 + tp]; sskv[tp] = sskp[tp] + sskp[256 + tp]; } }
  else {
    const int lane_s = opaque(lane);
#pragma unroll 1
    for (int rr = 0; rr < 32; rr += 8) {
      u32x2 a[8]; unsigned b[8];
#pragma unroll
      for (int u = 0; u < 8; ++u) { const size_t row = m0 + w * 32 + rr + u; a[u] = *(const u32x2*)(zq + row * 256 + lane_s * 4); b[u] = *(const unsigned*)(zkv + row * 128 + lane_s * 2); }
#pragma unroll
      for (int u = 0; u < 8; ++u) {
        const float q0 = __uint_as_float(a[u][0] << 16), q1 = __uint_as_float(a[u][0] & 0xffff0000u), q2 = __uint_as_float(a[u][1] << 16), q3 = __uint_as_float(a[u][1] & 0xffff0000u);
        const float k0 = __uint_as_float(b[u] << 16), k1 = __uint_as_float(b[u] & 0xffff0000u);
        float sq = q0 * q0 + q1 * q1 + q2 * q2 + q3 * q3, sk = k0 * k0 + k1 * k1;
#pragma unroll
        for (int o = 32; o > 0; o >>= 1) { sq += __shfl_xor(sq, o); sk += __shfl_xor(sk, o); }
        if (lane == 0) { ssq[w * 32 + rr + u] = sq; sskv[w * 32 + rr + u] = sk; }
      }
    }
  }
  __syncthreads();
  f32x16 acc[2][4];
  if (which & 1) {
#pragma unroll 1
    for (int ntile = 0; ntile < 3; ++ntile) {
      const int n0 = ntile * 256;
      const bf16_t* wuq = (const bf16_t*)(ws + WS_WUQ);
      const GNext nx = (ntile < 2) ? GNext{zq + (size_t)m0 * 256, 256, 16, 64, wuq + (size_t)(n0 + 256) * 256, 256, 64, 0, 4}
                     : ((which & 2) ? GNext{zkv + (size_t)m0 * 128, 128, 16, 64, (const bf16_t*)(ws + WS_WUKV), 128, 64, 0, 2} : GNext{nullptr, 0, 0, 0, nullptr, 0, 0, 0, 0});
      gemm256(zq + (size_t)m0 * 256, 256, 16, 64, 4, zq, 256, 16, 64, 0, wuq + (size_t)n0 * 256, 256, 64, lds, acc, G, ntile > 0);
      {
        const int lane_o = opaque(lane), l31 = lane_o & 31, hi = lane_o >> 5;
        const int cb = n0 + 64 * wn, d0 = cb % DQK;
#pragma unroll
        for (int mt = 0; mt < 4; ++mt) {
          const int rl = 128 * wm + 32 * mt + l31;
          const float rs = rsqrtf(ssq[rl] * (1.f / 256.f) + EPS);
          if (d0 == 128) {
            const float* rp = rope + ((size_t)(m0 + rl) * 32 + 4 * hi) * 2;
#pragma unroll
            for (int q = 0; q < 4; ++q) {
              const f32x4 t0 = *(const f32x4*)(rp + 16 * q), t1 = *(const f32x4*)(rp + 16 * q + 4);
              const float cs[4] = {t0[0], t0[2], t1[0], t1[2]}, sn[4] = {t0[1], t0[3], t1[1], t1[3]};
              float o1[4], o2[4];
#pragma unroll
              for (int e = 0; e < 4; ++e) { const float a = acc[0][mt][4 * q + e] * rs, bb = acc[1][mt][4 * q + e] * rs; o1[e] = a * cs[e] - bb * sn[e]; o2[e] = a * sn[e] + bb * cs[e]; }
              tile_put(lds, rl, 64 * wn + 8 * q + 4 * hi, pack2(o1[0], o1[1]), pack2(o1[2], o1[3]));
              tile_put(lds, rl, 64 * wn + 32 + 8 * q + 4 * hi, pack2(o2[0], o2[1]), pack2(o2[2], o2[3]));
            }
          } else {
#pragma unroll
            for (int nt = 0; nt < 2; ++nt)
#pragma unroll
              for (int q = 0; q < 4; ++q)
                tile_put(lds, rl, 64 * wn + 32 * nt + 8 * q + 4 * hi, pack2(acc[nt][mt][4 * q] * rs, acc[nt][mt][4 * q + 1] * rs), pack2(acc[nt][mt][4 * q + 2] * rs, acc[nt][mt][4 * q + 3] * rs));
          }
          __builtin_amdgcn_sched_barrier(0);
        }
      }
      gemm_preload(nx, G);
      __syncthreads();
      { const int col = n0 + (opaque(tid) & 31) * 8, h = col / DQK, d = col % DQK;
        tile_out(lds, Q + (((size_t)bat * NH + h) * SEQ + s0) * DQK + d, DQK, 1, 0, false); }
      __syncthreads();
    }
  }
  if (which & 2) {
#pragma unroll 1
    for (int ntile = 0; ntile < 4; ++ntile) {
      const int n0 = ntile * 256;
      const bf16_t* wukv = (const bf16_t*)(ws + WS_WUKV);
      const GNext nx = (ntile < 3) ? GNext{zkv + (size_t)m0 * 128, 128, 16, 64, wukv + (size_t)(n0 + 256) * 128, 128, 64, 0, 2} : GNext{nullptr, 0, 0, 0, nullptr, 0, 0, 0, 0};
      gemm256(zkv + (size_t)m0 * 128, 128, 16, 64, 2, zkv, 128, 16, 64, 0, wukv + (size_t)n0 * 128, 128, 64, lds, acc, G, ntile > 0 || (which & 1));
      {
        const int lane_o = opaque(lane), l31 = lane_o & 31, hi = lane_o >> 5;
#pragma unroll
        for (int mt = 0; mt < 4; ++mt) {
          const int rl = 128 * wm + 32 * mt + l31;
          const float rs = rsqrtf(sskv[rl] * (1.f / 128.f) + EPS);
#pragma unroll
          for (int nt = 0; nt < 2; ++nt)
#pragma unroll
            for (int q = 0; q < 4; ++q)
              tile_put(lds, rl, 64 * wn + 32 * nt + 8 * q + 4 * hi, pack2(acc[nt][mt][4 * q] * rs, acc[nt][mt][4 * q + 1] * rs), pack2(acc[nt][mt][4 * q + 2] * rs, acc[nt][mt][4 * q + 3] * rs));
          __builtin_amdgcn_sched_barrier(0);
        }
      }
      gemm_preload(nx, G);
      __syncthreads();
      { const int col = n0 + (opaque(tid) & 31) * 8, h = col >> 8, d = col & 255;
        bf16_t* base = (d < 128) ? Kf + (((size_t)bat * NH + h) * SEQ + s0) * DQK + d : V + (((size_t)bat * NH + h) * SEQ + s0) * DV + (d - 128);
        tile_out(lds, base, (d < 128) ? DQK : DV, 1, 0, false); }
      __syncthreads();
    }
  }
  __syncthreads();
}
#ifndef P3_ROT
#define P3_ROT 1
#endif
constexpr int L3_SSA = GEMM_LDS  , L3_SSS = GEMM_LDS + 1024  , L3_SSM = GEMM_LDS + 5120  ;

__device__ void phase3_tile(const Params& p, int mtile, char* lds) {
  GemmRegs G;
  char* ws = p.ws;
  const int tid = threadIdx.x, lane = tid & 63, w = tid >> 6, wm = w >> 2, wn = w & 3;
  const int m0 = mtile * 256;
  float* ssa = (float*)(lds + L3_SSA); float* sss = (float*)(lds + L3_SSS); float* ssm = (float*)(lds + L3_SSM);
  const bf16_t* ys = (const bf16_t*)(ws + WS_YS);
  const bf16_t* gat = (const bf16_t*)(ws + WS_GAT); const bf16_t* gss = (const bf16_t*)(ws + WS_GSS);
  bf16_t* amix = (bf16_t*)(ws + WS_AMIX); bf16_t* mixed = (bf16_t*)(ws + WS_MIXED);
  f32x16 acc[2][4];
  f32x4 acc4[4][8];
#pragma unroll 1
  for (int ntile = 0; ntile < 2; ++ntile) {
    const int n0 = ntile * 256;
    const bf16_t* wglu = (const bf16_t*)(ws + WS_WGLU); const bf16_t* wout = (const bf16_t*)(ws + WS_WOUT);
    const int rot3 = P3_ROT ? ((blockIdx.x >> 3) & 7) : 0;
    const GNext nxg = (ntile == 0) ? GNext{ys + (size_t)m0 * 16, 16, (size_t)NTOK * 16, 4 * ((size_t)NTOK * 16), wglu + (size_t)256 * 512, 512, 64, rot3, 8}
                                   : GNext{nullptr, 0, 0, 0, nullptr, 0, 0, 0, 0};
    gemm256(ys + (size_t)m0 * 16, 16, (size_t)NTOK * 16, 4 * ((size_t)NTOK * 16), 8, ys, 16, 16, 64, 0, wglu + (size_t)n0 * 512, 512, 64, lds, acc, G, ntile > 0, rot3);
    {
      const int lane_o = opaque(lane), l31 = lane_o & 31, hi = lane_o >> 5;
      const int cb = n0 + 64 * wn;
#pragma unroll
      for (int mt = 0; mt < 4; ++mt) {
        const int rl = 128 * wm + 32 * mt + l31, row = m0 + rl;
        float sq = 0.f;
#pragma unroll
        for (int nt = 0; nt < 2; ++nt)
#pragma unroll
          for (int q = 0; q < 4; ++q) {
            const int col = cb + 32 * nt + 8 * q + 4 * hi;
            const f32x4 bg = *(const f32x4*)(p.b_glu + col);
            const u32x2 yv = *(const u32x2*)(ys + ((size_t)(col >> 4) * NTOK + row) * 16 + (col & 15));
            const float y[4] = {__uint_as_float(yv[0] << 16), __uint_as_float(yv[0] & 0xffff0000u), __uint_as_float(yv[1] << 16), __uint_as_float(yv[1] & 0xffff0000u)};
            float v[4];
            const u32x2 gv = *(const u32x2*)(gss + (size_t)row * 512 + col);
            const float gg[4] = {__uint_as_float(gv[0] << 16), __uint_as_float(gv[0] & 0xffff0000u), __uint_as_float(gv[1] << 16), __uint_as_float(gv[1] & 0xffff0000u)};
#pragma unroll
            for (int e = 0; e < 4; ++e) { v[e] = y[e] * sigmoid_f(acc[nt][mt][4 * q + e] + bg[e]); sq += v[e] * v[e]; v[e] *= gg[e]; }
            tile_put(lds, rl, 64 * wn + 32 * nt + 8 * q + 4 * hi, pack2(v[0], v[1]), pack2(v[2], v[3]));
          }
        sq += __shfl_xor(sq, 32);
        if (hi == 0) { if (ntile == 0) sss[wn * 256 + rl] = sq; else sss[wn * 256 + rl] += sq; }
        __builtin_amdgcn_sched_barrier(0);
      }
    }
    gemm_preload(nxg, G);
    __syncthreads();
    tile_out(lds, amix + (size_t)m0 * 1024 + 512 + n0 + (opaque(tid) & 31) * 8, 1024, 1, 0);
    __syncthreads();
  }
  __syncthreads();
#pragma unroll 1
  for (int ntile = 0; ntile < 4; ++ntile) {
    const int n0 = ntile * 256;
    float resc[8];
    {
      const int lane_r = opaque(lane), l15r = lane_r & 15;
#pragma unroll
      for (int mt = 0; mt < 8; ++mt) {
        const int rl = 128 * wm + 16 * mt + l15r;
        const f32x4 sa = *(const f32x4*)((const float*)(ws + WS_SSA) + (size_t)(m0 + rl) * 4);
        const float ra = rsqrtf((sa[0] + sa[1] + sa[2] + sa[3]) * (1.f / 512.f) + EPS);
        resc[mt] = ra / rsqrtf((sss[rl] + sss[256 + rl] + sss[512 + rl] + sss[768 + rl]) * (1.f / 512.f) + EPS);
      }
    }
    const bf16_t* wout = (const bf16_t*)(ws + WS_WOUT);
    const int rot3 = P3_ROT ? ((blockIdx.x >> 3) & 7) : 0;
    gemm256_dma(amix + (size_t)m0 * 1024, 1024, 16, 64, 16, amix, 1024, 16, 64, 0, wout + (size_t)n0 * 1024, 1024, 64, lds, acc4, rot3, false, resc);
    {
      const int lane_o = opaque(lane), l15 = lane_o & 15, q4 = lane_o >> 4;
#pragma unroll
      for (int mt = 0; mt < 8; ++mt) {
        const int rl = 128 * wm + 16 * mt + l15;
        const float rsv = rsqrtf((sss[rl] + sss[256 + rl] + sss[512 + rl] + sss[768 + rl]) * (1.f / 512.f) + EPS);
        float sq = 0.f;
#pragma unroll
        for (int nt = 0; nt < 4; ++nt) {
          float v[4];
#pragma unroll
          for (int e = 0; e < 4; ++e) { v[e] = acc4[nt][mt][e] * rsv; sq += v[e] * v[e]; }
          tile_put(lds, rl, 64 * wn + 16 * nt + 4 * q4, pack2(v[0], v[1]), pack2(v[2], v[3]));
        }
        sq += __shfl_xor(sq, 16); sq += __shfl_xor(sq, 32);
        if (q4 == 0) { if (ntile == 0) ssm[wn * 256 + rl] = sq; else ssm[wn * 256 + rl] += sq; }
        if (mt & 1) __builtin_amdgcn_sched_barrier(0);
      }
    }
    __syncthreads();
    tile_out(lds, mixed + (size_t)m0 * 1024 + n0 + (opaque(tid) & 31) * 8, 1024, 1, 0);
    __syncthreads();
  }
  {
    const int tid_o = opaque(tid), c8 = (tid_o & 127) * 8;
    const f32x4 g0 = *(const f32x4*)(p.post_g + c8), g1 = *(const f32x4*)(p.post_g + c8 + 4);
#pragma unroll 1
    for (int r0 = tid_o >> 7; r0 < 256; r0 += 16) {
      bf16x8 mv[4]; f32x4 xa[4], xc[4];
#pragma unroll
      for (int u2 = 0; u2 < 4; ++u2) { const size_t row = m0 + r0 + 4 * u2; mv[u2] = *(const bf16x8*)(mixed + row * 1024 + c8); xa[u2] = __builtin_nontemporal_load((const f32x4*)(p.x + row * DM + c8)); xc[u2] = __builtin_nontemporal_load((const f32x4*)(p.x + row * DM + c8 + 4)); }
#pragma unroll
      for (int u2 = 0; u2 < 4; ++u2) {
        const int rl = r0 + 4 * u2;
        const float rs = rsqrtf((ssm[rl] + ssm[256 + rl] + ssm[512 + rl] + ssm[768 + rl]) * (1.f / DM) + EPS);
        f32x4 oa, oc;
#pragma unroll
        for (int e = 0; e < 4; ++e) { oa[e] = xa[u2][e] + bf2f((bf16_t)mv[u2][e]) * rs * g0[e]; oc[e] = xc[u2][e] + bf2f((bf16_t)mv[u2][4 + e]) * rs * g1[e]; }
        __builtin_nontemporal_store(oa, (f32x4*)(p.out + (size_t)(m0 + rl) * DM + c8)); __builtin_nontemporal_store(oc, (f32x4*)(p.out + (size_t)(m0 + rl) * DM + c8 + 4));
      }
    }
  }
  __syncthreads();
}
#ifndef ATT_LATE
#define ATT_LATE 1
#endif
#ifndef ATT_ROT
#define ATT_ROT 0
#endif
namespace att {
constexpr int NW = 8, QBLK = 32, KVBLK = 64;
constexpr float SCALE = 0.07216878364870322f;
constexpr float THR = 8.f;
constexpr int SHM_V = KVBLK * DV * 2, SHM_K = KVBLK * DQK * 2, LDS_ATTN = 2 * SHM_V + 2 * SHM_K + NW * 64 * 4;
#define SBAR() __builtin_amdgcn_sched_barrier(0)
__device__ __forceinline__ unsigned cvtpk(float lo, float hi) { unsigned r; asm volatile("v_cvt_pk_bf16_f32 %0, %1, %2" : "=v"(r) : "v"(lo), "v"(hi)); return r; }
__device__ __forceinline__ void dma16(const void* gsrc, unsigned lds_dst) {
  unsigned keep;
  asm volatile("s_mov_b32 %0, m0\n\ts_mov_b32 m0, %2\n\ts_nop 0\n\tglobal_load_lds_dwordx4 %1, off\n\ts_mov_b32 m0, %0" : "=&s"(keep) : "v"(gsrc), "s"(lds_dst) : "memory");
}
__device__ __forceinline__ int koff(int row, int c) { return row * 384 + ((c ^ ((row >> 1) & 7)) << 4); }

__device__ __forceinline__ void partialSM(f32x16& p0, f32x16& p1, float& m_reg, float& mn, float& alpha) {
  constexpr float C = SCALE * 1.4426950408889634f;
  float pmax = p0[0];
#pragma unroll
  for (int r = 1; r < 16; ++r) pmax = fmaxf(pmax, p0[r]);
#pragma unroll
  for (int r = 0; r < 16; ++r) pmax = fmaxf(pmax, p1[r]);
  { auto rr = __builtin_amdgcn_permlane32_swap(__float_as_uint(pmax), __float_as_uint(pmax), false, false);
    pmax = fmaxf(__uint_as_float(rr[0]), __uint_as_float(rr[1])); }
  if (__builtin_expect(__all(pmax - m_reg <= THR / SCALE), 1)) { mn = m_reg; alpha = 1.f; }
  else { mn = fmaxf(m_reg, pmax); alpha = __builtin_amdgcn_exp2f((m_reg - mn) * C); m_reg = mn; }
  const float mnC = -mn * C;
#pragma unroll
  for (int r = 0; r < 16; ++r) p0[r] = fmaf(p0[r], C, mnC);
#pragma unroll
  for (int r = 0; r < 16; ++r) p1[r] = fmaf(p1[r], C, mnC);
#pragma unroll
  for (int r = 0; r < 16; ++r) p0[r] = __builtin_amdgcn_exp2f(p0[r]);
}
__device__ __forceinline__ void finishSM(f32x16& p0, f32x16& p1, float alpha, float& l_reg, bf16x8& pa0, bf16x8& pa1, bf16x8& pa2, bf16x8& pa3) {
#pragma unroll
  for (int r = 0; r < 16; ++r) p1[r] = __builtin_amdgcn_exp2f(p1[r]);
  float ps = 0;
#pragma unroll
  for (int r = 0; r < 16; ++r) ps += p0[r];
#pragma unroll
  for (int r = 0; r < 16; ++r) ps += p1[r];
  { auto rr = __builtin_amdgcn_permlane32_swap(__float_as_uint(ps), __float_as_uint(ps), false, false);
    ps = __uint_as_float(rr[0]) + __uint_as_float(rr[1]); }
  l_reg = l_reg * alpha + ps;
#define PK4(P, BASE, OUT) do { unsigned a0 = cvtpk(P[BASE + 0], P[BASE + 1]), a1 = cvtpk(P[BASE + 2], P[BASE + 3]);   \
    unsigned b0 = cvtpk(P[BASE + 4], P[BASE + 5]), b1 = cvtpk(P[BASE + 6], P[BASE + 7]);                              \
    auto r0 = __builtin_amdgcn_permlane32_swap(a0, b0, false, false); auto r1 = __builtin_amdgcn_permlane32_swap(a1, b1, false, false); \
    u32x4 w = {r0[0], r1[0], r0[1], r1[1]}; OUT = *reinterpret_cast<bf16x8*>(&w); } while (0)
  PK4(p0, 0, pa0); PK4(p0, 8, pa1); PK4(p1, 0, pa2); PK4(p1, 8, pa3);
#undef PK4
}
__device__ __forceinline__ void qkt(f32x16& p0, f32x16& p1, const char* Ks, const bf16x8* qr, int r32, int hi) {
#pragma unroll
  for (int r = 0; r < 16; ++r) { p0[r] = 0.f; p1[r] = 0.f; }
  const int sw = (r32 >> 1) & 7; const char* k0p = Ks + r32 * 384; const char* k1p = k0p + 32 * 384;
#pragma unroll
  for (int d0 = 0; d0 < 12; ++d0) { const int off = ((2 * d0 + hi) ^ sw) << 4;
    const bf16x8 b0 = *reinterpret_cast<const bf16x8*>(k0p + off);
    const bf16x8 b1 = *reinterpret_cast<const bf16x8*>(k1p + off);
    p0 = __builtin_amdgcn_mfma_f32_32x32x16_bf16(b0, qr[d0], p0, 0, 0, 0);
    p1 = __builtin_amdgcn_mfma_f32_32x32x16_bf16(b1, qr[d0], p1, 0, 0, 0);
    if ((d0 & 3) == 3) SBAR(); }
}
__device__ __forceinline__ int v_st(int k, int c) { const int kk = (k & ~0xC) | ((k & 4) << 1) | ((k & 8) >> 1); return ((kk >> 3) * 4 + (c >> 5)) * 512 + ((kk & 7) * 32 + (c & 31)) * 2; }
__device__ __forceinline__ int v_rd_base(int lane) { return ((lane & 3) << 3) | (((lane >> 2) & 3) << 6) | (((lane >> 4) & 1) << 5) | (((lane >> 5) & 1) << 8); }
constexpr int v_rd_off(int d0, int ks, int half) { return d0 * 512 + ks * 4096 + half * 2048; }
template <int OFF> __device__ __forceinline__ s16x4 tr_read(int vb) {
  s16x4 r; asm volatile("ds_read_b64_tr_b16 %0, %1 offset:%2" : "=&v"(r) : "v"(vb), "i"(OFF) : "memory"); return r;
}
template <int D0> __device__ __forceinline__ void pv_one(f32x16& od, int vb, bf16x8 pa0, bf16x8 pa1, bf16x8 pa2, bf16x8 pa3) {
  const s16x4 l0 = tr_read<v_rd_off(D0, 0, 0)>(vb), h0 = tr_read<v_rd_off(D0, 0, 1)>(vb), l1 = tr_read<v_rd_off(D0, 1, 0)>(vb), h1 = tr_read<v_rd_off(D0, 1, 1)>(vb);
  const s16x4 l2 = tr_read<v_rd_off(D0, 2, 0)>(vb), h2 = tr_read<v_rd_off(D0, 2, 1)>(vb), l3 = tr_read<v_rd_off(D0, 3, 0)>(vb), h3 = tr_read<v_rd_off(D0, 3, 1)>(vb);
  asm volatile("s_waitcnt lgkmcnt(0)" ::: "memory"); SBAR();
#define PK(L, H) (bf16x8){L[0], L[1], L[2], L[3], H[0], H[1], H[2], H[3]}
  od = __builtin_amdgcn_mfma_f32_32x32x16_bf16(pa0, PK(l0, h0), od, 0, 0, 0);
  od = __builtin_amdgcn_mfma_f32_32x32x16_bf16(pa1, PK(l1, h1), od, 0, 0, 0);
  od = __builtin_amdgcn_mfma_f32_32x32x16_bf16(pa2, PK(l2, h2), od, 0, 0, 0);
  od = __builtin_amdgcn_mfma_f32_32x32x16_bf16(pa3, PK(l3, h3), od, 0, 0, 0);
#undef PK
}
__device__ __forceinline__ void pv_d0(f32x16* o, int vb, bf16x8 pa0, bf16x8 pa1, bf16x8 pa2, bf16x8 pa3) {
  pv_one<0>(o[0], vb, pa0, pa1, pa2, pa3); pv_one<1>(o[1], vb, pa0, pa1, pa2, pa3); pv_one<2>(o[2], vb, pa0, pa1, pa2, pa3); pv_one<3>(o[3], vb, pa0, pa1, pa2, pa3);
}

__device__ __forceinline__ void unit(const bf16_t* __restrict__ Qb, const bf16_t* __restrict__ Kh, const bf16_t* __restrict__ Vh, bf16_t* __restrict__ Ob, const bf16_t* __restrict__ Gb, float* __restrict__ Sb, char* lds, int j0 = 0) {
  const int tid = threadIdx.x, wid = __builtin_amdgcn_readfirstlane(tid >> 6), lane = tid & 63, r32 = lane & 31, hi = lane >> 5;
  char* V_lds = lds; char* K_lds = lds + 2 * SHM_V;
  float* wsf = (float*)(lds + 2 * SHM_V + 2 * SHM_K) + wid * 64; float* li_l = wsf; float* al_l = wsf + 32;
  float m_reg = -1e30f, l_reg = 0; f32x16 o[4]; bf16x8 qr[12];
#pragma unroll
  for (int d = 0; d < 4; ++d)
#pragma unroll
    for (int r = 0; r < 16; ++r) o[d][r] = 0.f;
  const bf16_t* Qw = Qb + (size_t)(wid * QBLK + r32) * DQK + hi * 8;
#pragma unroll
  for (int d0 = 0; d0 < 12; ++d0) qr[d0] = *reinterpret_cast<const bf16x8*>(Qw + d0 * 16);
#pragma unroll
  for (int d0 = 0; d0 < 12; ++d0) asm volatile("" : "+v"(qr[d0]));
  unsigned ksrc[3], vsrc[2];
#pragma unroll
  for (int i = 0; i < 3; ++i) { const int s = (i * 8 + wid) * 64 + lane, row = s / 24, cp = s - row * 24, c = (cp & ~7) | ((cp & 7) ^ ((row >> 1) & 7)); ksrc[i] = row * DQK + c * 8; }
#pragma unroll
  for (int i = 0; i < 2; ++i) { const int s = (i * 8 + wid) * 64 + lane, sub = s >> 5, within = s & 31, kk = (sub >> 2) * 8 + (within >> 2);
    const int k = (kk & ~0xC) | ((kk & 4) << 1) | ((kk & 8) >> 1), c = (sub & 3) * 32 + (within & 3) * 8; vsrc[i] = k * DV + c; }
  const unsigned ldsb = (unsigned)(uintptr_t)lds;
  const int vb0 = (int)(uintptr_t)V_lds + v_rd_base(lane);
#define KDMA(b, k0) do { const int k0_ = (k0), b_ = (b); _Pragma("unroll") for (int q_ = 0; q_ < 3; ++q_) dma16(Kh + (size_t)k0_ * DQK + ksrc[q_], __builtin_amdgcn_readfirstlane(ldsb + 2 * SHM_V + b_ * SHM_K + (q_ * 8 + wid) * 1024)); } while (0)
#define VDMA(b, k0) do { const int k0_ = (k0), b_ = (b); _Pragma("unroll") for (int q_ = 0; q_ < 2; ++q_) dma16(Vh + (size_t)k0_ * DV + vsrc[q_], __builtin_amdgcn_readfirstlane(ldsb + b_ * SHM_V + (q_ * 8 + wid) * 1024)); } while (0)
#define VMWAIT(n) asm volatile("s_waitcnt vmcnt(" #n ")" ::: "memory")
#define RESC(a) do { if (__any((a) < 1.f)) { if (hi == 0) al_l[r32] = (a); asm volatile("s_waitcnt lgkmcnt(0)" ::: "memory"); \
    _Pragma("unroll") for (int d = 0; d < 4; ++d) _Pragma("unroll") for (int r = 0; r < 16; ++r) o[d][r] *= al_l[crow(r, hi)]; } } while (0)
  f32x16 p0, p1; float mn, al; bf16x8 pa0, pa1, pa2, pa3; constexpr int NT = SEQ / KVBLK;
  const bool late = (ATT_LATE) && wid >= 4;
#define XPH(b) do { SBAR(); __builtin_amdgcn_s_setprio(1); qkt(p0, p1, K_lds + (b) * SHM_K, qr, r32, hi); __builtin_amdgcn_s_setprio(0); partialSM(p0, p1, m_reg, mn, al); SBAR(); } while (0)
#define YPH(b) do { SBAR(); RESC(al); finishSM(p0, p1, al, l_reg, pa0, pa1, pa2, pa3); SBAR(); __builtin_amdgcn_s_setprio(1); pv_d0(o, vb0 + (b) * SHM_V, pa0, pa1, pa2, pa3); __builtin_amdgcn_s_setprio(0); SBAR(); } while (0)
#define TILE(t) ((((t) + j0) & (NT - 1)) * KVBLK)
  KDMA(0, TILE(0)); VDMA(0, TILE(0)); VMWAIT(0); __syncthreads();
  if (late) { KDMA(1, TILE(1)); VMWAIT(3); __syncthreads(); }
#pragma unroll 1
  for (int i = 0; i < NT; ++i) {
    const int buf = i & 1;
    if (!late) { if (i + 1 < NT) { KDMA(buf ^ 1, TILE(i + 1)); } } else { if (i + 1 < NT) { VDMA(buf ^ 1, TILE(i + 1)); } }
    XPH(buf);
    if (i + 1 < NT) { if (!late) VMWAIT(3); else VMWAIT(2); } else VMWAIT(0);
    __syncthreads();
    if (!late) { if (i + 1 < NT) { VDMA(buf ^ 1, TILE(i + 1)); } } else { if (i + 2 < NT) { KDMA(buf, TILE(i + 2)); } }
    YPH(buf);
    if (!late) { if (i + 1 < NT) VMWAIT(2); else VMWAIT(0); } else { if (i + 2 < NT) VMWAIT(3); else VMWAIT(0); }
    __syncthreads();
  }
  if (!late) __syncthreads();
#undef XPH
#undef YPH
#undef TILE
  if (hi == 0) li_l[r32] = l_reg; asm volatile("s_waitcnt lgkmcnt(0)" ::: "memory");
  float rli[16];
#pragma unroll
  for (int r = 0; r < 16; ++r) rli[r] = __builtin_amdgcn_rcpf(li_l[crow(r, hi)]);
  char* ow = lds + wid * 8192;
  {
    const int r32e = opaque(r32);
    const bool odd = r32e & 1;
#pragma unroll
    for (int r = 0; r < 16; r += 2) {
      const int orow = crow(r, hi) + (odd ? 1 : 0);
#pragma unroll
      for (int d0 = 0; d0 < 4; ++d0) {
        const float a = o[d0][r] * rli[r], b = o[d0][r + 1] * rli[r + 1];
        const float x = __shfl_xor(odd ? a : b, 1);
        const unsigned w = odd ? pack2(x, b) : pack2(a, x);
        const int col = d0 * 32 + (r32e & ~1);
        *(unsigned*)(ow + orow * 256 + ((((col >> 3) ^ orow) & 15) << 4) + ((col & 7) << 1)) = w;
      }
    }
  }
  asm volatile("s_waitcnt lgkmcnt(0)" ::: "memory");
  {
    const int le = opaque(lane), chunk = le & 15, rsub = le >> 4;
    bf16_t* Ow = Ob + (size_t)(wid * QBLK) * 1024 + chunk * 8; const bf16_t* Gw = Gb + (size_t)(wid * QBLK) * AW + chunk * 8; float* Sw = Sb + (size_t)(wid * QBLK) * 4;
    u32x4 gv[8];
#pragma unroll
    for (int i = 0; i < 8; ++i) gv[i] = *(const u32x4*)(Gw + (size_t)(4 * i + rsub) * AW);
#pragma unroll
    for (int i = 0; i < 8; ++i) {
      const int row = 4 * i + rsub;
      const u32x4 ov = *(const u32x4*)(ow + row * 256 + (((chunk ^ row) & 15) << 4));
      float s = 0.f; u32x4 wv;
#pragma unroll
      for (int e = 0; e < 4; ++e) {
        const float o0 = __uint_as_float(ov[e] << 16), o1 = __uint_as_float(ov[e] & 0xffff0000u);
        s += o0 * o0 + o1 * o1;
        wv[e] = pack2(o0 * __uint_as_float(gv[i][e] << 16), o1 * __uint_as_float(gv[i][e] & 0xffff0000u));
      }
      *(u32x4*)(Ow + (size_t)row * 1024) = wv;
      s += __shfl_xor(s, 1); s += __shfl_xor(s, 2); s += __shfl_xor(s, 4); s += __shfl_xor(s, 8);
      if (chunk == 0) Sw[row * 4] = s;
    }
  }
  __syncthreads();
#undef KDMA
#undef VDMA
#undef VMWAIT
#undef RESC
}
}

__device__ __forceinline__ void attn_unit(const Params& p, int u, char* lds) {
  const int qb = u & 7, bh = u >> 3;
  const bf16_t* Q = (const bf16_t*)(p.ws + WS_Q); const bf16_t* Kf = (const bf16_t*)(p.ws + WS_K); const bf16_t* V = (const bf16_t*)(p.ws + WS_V); bf16_t* amix = (bf16_t*)(p.ws + WS_AMIX); const bf16_t* gat = (const bf16_t*)(p.ws + WS_GAT); float* ssa = (float*)(p.ws + WS_SSA);
  const int b = bh >> 2, h = bh & 3;
  att::unit(Q + ((size_t)bh * SEQ + qb * 256) * DQK, Kf + (size_t)bh * SEQ * DQK, V + (size_t)bh * SEQ * DV, amix + ((size_t)b * SEQ + qb * 256) * 1024 + h * DV, gat + ((size_t)b * SEQ + qb * 256) * AW + h * DV, ssa + ((size_t)b * SEQ + qb * 256) * 4 + h, lds, ATT_ROT * qb);
}
__device__ void s5_unit(const Params& p, int unit, char* lds, char* scr) {
  GemmRegs G;
  const int g = unit & 31, j = unit >> 5;
  const int tid = threadIdx.x, lane = tid & 63, w = tid >> 6, wm = w >> 2, wn = w & 3;
  const bf16_t* U = (const bf16_t*)(p.ws + WS_US) + ((size_t)g * NTOK + (size_t)j * 4096) * 16;
  bf16_t* carry = (bf16_t*)scr;
  f32x16 acc[2][4];
  const bf16_t* mq = (const bf16_t*)(p.ws + WS_S5MQ) + (size_t)g * 131072;
  gemm256(U, 256, 16, 64, 4, U, 256, 16, 64, 0, (const bf16_t*)(p.ws + WS_S5P) + (size_t)g * 65536, 256, 64, lds, acc, G, false);
  {
    const int lane_o = opaque(lane), l31 = lane_o & 31, hi = lane_o >> 5;
#pragma unroll
    for (int mt = 0; mt < 4; ++mt) {
      const int r = 128 * wm + 32 * mt + l31;
#pragma unroll
      for (int nt = 0; nt < 2; ++nt)
#pragma unroll
        for (int q = 0; q < 4; ++q)
          tile_put(lds, r, 64 * wn + 32 * nt + 8 * q + 4 * hi, pack2(acc[nt][mt][4 * q], acc[nt][mt][4 * q + 1]), pack2(acc[nt][mt][4 * q + 2], acc[nt][mt][4 * q + 3]));
      __builtin_amdgcn_sched_barrier(0);
    }
  }
  gemm_preload(GNext{U, 256, 16, 64, mq, 512, 64, 0, 8}, G);
  __syncthreads();
  if (tid < 256) {
    const int bb = tid >> 7, idx = tid & 127, dir = idx >> 6, n = 2 * idx;
    const f32x2 lt = ((const f32x2*)(p.ws + WS_S5LT))[g * 128 + idx];
    float hr = 0.f, hi_ = 0.f;
#pragma unroll 8
    for (int cc = 0; cc < 128; ++cc) {
      const int c = dir ? 127 - cc : cc, r = bb * 128 + c;
      const unsigned sv = *(const unsigned*)(lds + r * 512 + ((((n >> 3) ^ r) & 31) << 4) + ((n & 7) << 1));
      *(unsigned*)(carry + (size_t)r * 256 + n) = pack2(hr, hi_);
      const float sr = __uint_as_float(sv << 16), si = __uint_as_float(sv & 0xffff0000u);
      const float nr = lt[0] * hr - lt[1] * hi_ + sr, ni = lt[0] * hi_ + lt[1] * hr + si;
      hr = nr; hi_ = ni;
    }
  }
  __syncthreads();
  gemm256(U, 256, 16, 64, 4, carry, 256, 16, 64, 4, mq, 512, 64, lds, acc, G, true);
  {
    const int lane_o = opaque(lane), l31 = lane_o & 31, hi = lane_o >> 5;
#pragma unroll
    for (int mt = 0; mt < 4; ++mt) {
      const int r = 128 * wm + 32 * mt + l31;
#pragma unroll
      for (int nt = 0; nt < 2; ++nt)
#pragma unroll
        for (int q = 0; q < 4; ++q) {
          const int n = 64 * wn + 32 * nt + 8 * q + 4 * hi;
          const u32x2 uv = *(const u32x2*)(U + (size_t)r * 256 + n);
          const f32x4 dv = *(const f32x4*)(p.s5d + g * 16 + (n & 15));
          const float u[4] = {__uint_as_float(uv[0] << 16), __uint_as_float(uv[0] & 0xffff0000u), __uint_as_float(uv[1] << 16), __uint_as_float(uv[1] & 0xffff0000u)};
          float y[4];
#pragma unroll
          for (int e = 0; e < 4; ++e) y[e] = gelu_tanh_f(acc[nt][mt][4 * q + e] + dv[e] * u[e]);
          tile_put(lds, r, n, pack2(y[0], y[1]), pack2(y[2], y[3]));
        }
      __builtin_amdgcn_sched_barrier(0);
    }
  }
  __syncthreads();
  tile_out(lds, (bf16_t*)(p.ws + WS_YS) + ((size_t)g * NTOK + (size_t)j * 4096) * 16 + (opaque(tid) & 31) * 8, 256, 1, 0);
  __syncthreads();
}
namespace cg = cooperative_groups;
#ifndef REP_P0
#define REP_P0 1
#endif
#ifndef REP_P1
#define REP_P1 1
#endif
#ifndef REP_P1B
#define REP_P1B 1
#endif
#ifndef REP_S5
#define REP_S5 1
#endif
#ifndef REP_AT
#define REP_AT 1
#endif
#ifndef REP_P3
#define REP_P3 1
#endif

constexpr int LDS_BYTES = GEMM_LDS + 16384;

__global__ __launch_bounds__(512, 1) void hymba_megakernel(Params p) {
  extern __shared__ __attribute__((aligned(16))) char lds[];
  cg::grid_group grid = cg::this_grid();
  const int nblk = gridDim.x, bid = blockIdx.x;
  for (int rep = 0; rep < REP_P0; ++rep) { prep_phase(p, bid, nblk, (float*)lds); }
  grid.sync();
  for (int rep = 0; rep < REP_P1; ++rep) {
    const bool g256 = (nblk == 256);
    const int x = bid & 7, c = bid >> 3, mrow = c >> 3, nc0 = c & 7;
    const int iters = g256 ? 8 : 8 * ((NTOK / 256 - bid + nblk - 1) / nblk);
#pragma unroll 1
    for (int it = 0; it < iters; ++it) {
      const int nt = g256 ? ((nc0 + it) & 7) : (it & 7), mt_ = g256 ? 32 * x + 4 * it + mrow : bid + (it >> 3) * nblk;
      const int up = g256 ? (nt < 2 ? nt + 1 : 0) : (nt == 7 ? 3 : 0);
      phase1_win(p, mt_, nt, lds, 0);
      if (up) phase1_up(p, mt_, up, lds, g256);
    }
  }
  grid.sync();
  {
    const int x = bid & 7, c = bid >> 3;
    char* scr = p.ws + WS_SCR + (size_t)bid * 393216;
    const bool g256 = (nblk == 256);
    const int n5 = g256 ? 2 : (512 - bid + nblk - 1) / nblk, na = g256 ? 4 : (NB * NH * 8 - bid + nblk - 1) / nblk;
    const bool s5first = ((bid >> 6) & 1) == 0;
    if (s5first) {
    for (int rep = 0; rep < REP_S5; ++rep)
#pragma unroll 1
      for (int r = 0; r < n5; ++r) s5_unit(p, g256 ? (4 * x + (c & 3)) + 32 * ((c >> 2) + 8 * r) : bid + r * nblk, lds, scr);
    }
    for (int rep = 0; rep < REP_AT; ++rep)
#pragma unroll 1
      for (int r = 0; r < na; ++r) attn_unit(p, g256 ? ((((4 * x + (3 - r)) * 4 + (c >> 3))) << 3) + (c & 7) : bid + r * nblk, lds);
    if (!s5first) {
    for (int rep = 0; rep < REP_S5; ++rep)
#pragma unroll 1
      for (int r = 0; r < n5; ++r) s5_unit(p, g256 ? (4 * x + (c & 3)) + 32 * ((c >> 2) + 8 * r) : bid + r * nblk, lds, scr);
    }
  }
  grid.sync();
  for (int rep = 0; rep < REP_P3; ++rep) for (int t = bid; t < NTOK / 256; t += nblk) phase3_tile(p, (nblk == 256) ? 32 * (bid & 7) + (bid >> 3) : t, lds);
}

static Params make_params(void* const* d_in, void* d_out, void* d_ws) {
  Params p{};
  p.x = (const float*)d_in[0]; p.pos = (const int*)d_in[1]; p.pre_g = (const float*)d_in[2]; p.w_in = (const float*)d_in[3]; p.q_g = (const float*)d_in[4];
  p.w_uq = (const float*)d_in[5]; p.kv_g = (const float*)d_in[6]; p.w_ukv = (const float*)d_in[7]; p.ao_g = (const float*)d_in[8]; p.lam_re = (const float*)d_in[9];
  p.lam_im = (const float*)d_in[10]; p.log_dt = (const float*)d_in[11]; p.b_re = (const float*)d_in[12]; p.b_im = (const float*)d_in[13]; p.c_re = (const float*)d_in[14];
  p.c_im = (const float*)d_in[15]; p.s5d = (const float*)d_in[16]; p.w_glu = (const float*)d_in[17]; p.b_glu = (const float*)d_in[18]; p.so_g = (const float*)d_in[19];
  p.w_out = (const float*)d_in[20]; p.post_g = (const float*)d_in[21]; p.out = (float*)d_out; p.ws = (char*)d_ws;
  return p;
}

extern "C" void kernel_launch(void* const* d_in, const int* in_sizes, int n_in, void* d_out, int out_size, void* d_ws, size_t ws_size, hipStream_t stream) {
  if (n_in != 22 || in_sizes[0] != NTOK * DM || out_size != NTOK * DM || ws_size < WS_END) {
    fprintf(stderr, "kernel_launch: shape mismatch n_in %d in0 %d out %d ws %zu (need %zu)\n", n_in, n_in > 0 ? in_sizes[0] : -1, out_size, ws_size, (size_t)WS_END);
    return;
  }
  static int grid_blocks = 0;
  if (!grid_blocks) {
    if (hipFuncSetAttribute((const void*)hymba_megakernel, hipFuncAttributeMaxDynamicSharedMemorySize, LDS_BYTES) != hipSuccess) { fprintf(stderr, "kernel_launch: LDS attribute failed\n"); return; }
    int dev = 0, cus = 0, per_cu = 0;
    (void)hipGetDevice(&dev);
    (void)hipDeviceGetAttribute(&cus, hipDeviceAttributeMultiprocessorCount, dev);
    (void)hipOccupancyMaxActiveBlocksPerMultiprocessor(&per_cu, hymba_megakernel, 512, LDS_BYTES);
    if (per_cu < 1 || cus < 1) { fprintf(stderr, "kernel_launch: occupancy query gave %d blocks/CU on %d CUs\n", per_cu, cus); return; }
    grid_blocks = cus;
  }
  Params p = make_params(d_in, d_out, d_ws);
  void* args[] = {&p};
  hipError_t e = hipLaunchCooperativeKernel((void*)hymba_megakernel, dim3(grid_blocks), dim3(512), args, LDS_BYTES, stream);
  if (e != hipSuccess) fprintf(stderr, "cooperative launch failed: %s (grid %d)\n", hipGetErrorString(e), grid_blocks);
}
```

```cpp
#include <hip/hip_runtime.h>
#include <hip/hip_cooperative_groups.h>
#include <stdint.h>
#include <cstdio>

typedef unsigned short bf16_t;
typedef short bf16x8 __attribute__((ext_vector_type(8)));
typedef short s16x4 __attribute__((ext_vector_type(4)));
typedef float f32x16 __attribute__((ext_vector_type(16)));
typedef float f32x4 __attribute__((ext_vector_type(4)));
typedef float f32x2 __attribute__((ext_vector_type(2)));
typedef unsigned u32x4 __attribute__((ext_vector_type(4)));
typedef unsigned u32x2 __attribute__((ext_vector_type(2)));

__device__ __forceinline__ float bf2f(bf16_t v) { return __uint_as_float(((unsigned)v) << 16); }
__device__ __forceinline__ bf16_t f2bf(float f) { unsigned u = __float_as_uint(f); u += 0x7fffu + ((u >> 16) & 1u); return (bf16_t)(u >> 16); }
__device__ __forceinline__ unsigned pack2(float lo, float hi) { unsigned r; asm("v_cvt_pk_bf16_f32 %0, %1, %2" : "=v"(r) : "v"(lo), "v"(hi)); return r; }
__device__ __forceinline__ float sigmoid_f(float v) { return __builtin_amdgcn_rcpf(1.f + __builtin_amdgcn_exp2f(-1.4426950408889634f * v)); }
__device__ __forceinline__ float silu_f(float v) { return v * sigmoid_f(v); }
__device__ __forceinline__ float gelu_tanh_f(float v) {
  const float u2 = 1.5957691216057308f * v * fmaf(0.044715f * v, v, 1.f);
  return v * sigmoid_f(u2);
}

__device__ __forceinline__ int opaque(int x) { asm volatile("" : "+v"(x)); return x; }
constexpr int NB = 32, SEQ = 2048, DM = 1024, NTOK = NB * SEQ;
constexpr int QR = 256, KVR = 128, ROPE = 64, AW = 512, SW = 512, DIN = 1984, DINP = 2048;
constexpr int NH = 4, DQK = 192, DV = 128;
constexpr int SG = 32, SH = 16, SP = 64;
constexpr float EPS = 1e-6f;
constexpr int C_ZQ = 0, C_ZKV = 256, C_ZKR = 384, C_GA = 448, C_US = 960, C_GS = 1472;

constexpr size_t al256(size_t x) { return (x + 255) / 256 * 256; }
constexpr size_t WS_WIN = 0;
constexpr size_t WS_WUQ = WS_WIN + (size_t)DINP * DM * 2;
constexpr size_t WS_WUKV = WS_WUQ + (size_t)768 * 256 * 2;
constexpr size_t WS_WGLU = WS_WUKV + (size_t)1024 * 128 * 2;
constexpr size_t WS_WOUT = WS_WGLU + (size_t)512 * 512 * 2;
constexpr size_t WS_S5P = WS_WOUT + (size_t)1024 * 1024 * 2;
constexpr size_t WS_S5MQ = WS_S5P + (size_t)32 * 256 * 256 * 2;
constexpr size_t WS_S5LT = WS_S5MQ + (size_t)32 * 256 * 512 * 2;
constexpr size_t WS_RSX = al256(WS_S5LT + (size_t)32 * 2 * 64 * 2 * 4);
constexpr size_t WS_RSQ = WS_RSX + (size_t)NTOK * 4;
constexpr size_t WS_RSKV = WS_RSQ + (size_t)NTOK * 4;
constexpr size_t WS_GAT = WS_RSKV + (size_t)NTOK * 4;
constexpr size_t WS_GSS = WS_GAT + (size_t)NTOK * 512 * 2;
constexpr size_t WS_US = WS_GSS + (size_t)NTOK * 512 * 2;
constexpr size_t WS_Q = WS_US + (size_t)NTOK * 512 * 2;
constexpr size_t WS_K = WS_Q + (size_t)NTOK * NH * DQK * 2;
constexpr size_t WS_V = WS_K + (size_t)NTOK * NH * DQK * 2;
constexpr size_t WS_XB = WS_V + (size_t)NTOK * NH * DV * 2;
constexpr size_t WS_ROPE = WS_XB + (size_t)NTOK * DM * 2;
constexpr size_t WS_ZQ = WS_ROPE + (size_t)NTOK * 64 * 4;
constexpr size_t WS_ZKV = WS_ZQ + (size_t)NTOK * 256 * 2;
constexpr size_t WS_O = WS_ZKV + (size_t)NTOK * 128 * 2;
constexpr size_t WS_YS = WS_O + (size_t)NTOK * 512 * 2;
constexpr size_t WS_SCR = WS_YS + (size_t)NTOK * 512 * 2;
constexpr size_t WS_BAR = WS_SCR + (size_t)256 * 393216;
constexpr size_t WS_SSA = WS_BAR + 4096;
constexpr size_t WS_END = WS_SSA + (size_t)NTOK * 16;
constexpr size_t WS_AMIX = WS_ROPE;
constexpr size_t WS_MIXED = WS_Q;
static_assert(WS_END <= (size_t)1024 * 1024 * 1024, "workspace exceeds 1 GiB");
static_assert((size_t)NTOK * 1024 * 4 <= WS_XB - WS_Q, "mixed alias too large");
static_assert((size_t)NTOK * 1024 * 2 <= WS_YS - WS_ROPE, "amix alias too large");

__device__ __forceinline__ bf16_t* amix_tile(char* ws, int t) {
  const int x = t >> 5, k = t & 31;
  const size_t off = k < 4 ? WS_ROPE + (size_t)x * 2097152 + (size_t)k * 524288 : k < 12 ? WS_ZQ + (size_t)x * 4194304 + (size_t)(k - 4) * 524288
                   : k < 16 ? WS_ZKV + (size_t)x * 2097152 + (size_t)(k - 12) * 524288 : WS_O + (size_t)x * 8388608 + (size_t)(k - 16) * 524288;
  return (bf16_t*)(ws + off);
}
__device__ __forceinline__ bf16_t* mixed_tile(char* ws, int t) {
  const int b = t >> 3, k = t & 7;
  return (bf16_t*)(ws + (k < 6 ? WS_Q + (size_t)b * 3145728 + (size_t)k * 524288 : WS_K + (size_t)b * 3145728 + (size_t)(k - 6) * 524288));
}
static_assert((size_t)NTOK / 8 * 64 * 4 == 2097152 && (size_t)NTOK / 8 * 256 * 2 == 4194304 && (size_t)NTOK / 8 * 512 * 2 == 8388608 && (size_t)NH * SEQ * DQK * 2 == 3145728, "tile alias slices");

struct Params {
  const float* x; const int* pos; const float* pre_g; const float* w_in; const float* q_g; const float* w_uq; const float* kv_g; const float* w_ukv;
  const float* ao_g; const float* lam_re; const float* lam_im; const float* log_dt; const float* b_re; const float* b_im; const float* c_re; const float* c_im;
  const float* s5d; const float* w_glu; const float* b_glu; const float* so_g; const float* w_out; const float* post_g;
  float* out; char* ws;
};

__device__ __forceinline__ void transpose_tile(const float* __restrict__ src, int Nsrc, const float* __restrict__ g0, const float* __restrict__ g1, int gsplit,
                                               bf16_t* __restrict__ dst, int K, int n0, int k0, float* tile, bool tiled = false) {
  const int tid = threadIdx.x;
  const int c = tid & 63, r0 = tid >> 6, n = n0 + c;
  float v[8], gg[8];
#pragma unroll
  for (int i = 0; i < 8; ++i) { const int k = k0 + r0 + 8 * i; v[i] = (n < Nsrc) ? src[(size_t)k * Nsrc + n] : 0.f; gg[i] = g0 ? (k < gsplit ? g0[k] : g1[k - gsplit]) : 1.f; }
#pragma unroll
  for (int i = 0; i < 8; ++i) tile[(r0 + 8 * i) * 65 + c] = v[i] * gg[i];
  __syncthreads();
#pragma unroll
  for (int i = 0; i < 8; ++i) { const int rr = r0 + 8 * i, n = n0 + rr, k = k0 + c;
    const size_t di = tiled ? ((size_t)((n >> 8) * (K >> 5) + (k >> 5)) * 8192 + (size_t)(n & 255) * 32 + (k & 31)) : ((size_t)n * K + k);
    dst[di] = f2bf(tile[c * 65 + rr]); }
  __syncthreads();
}

__device__ void prep_xconv(const Params& p, int slot0, int myslots, int nslot, int xcd);
__device__ void prep_s5_group(const Params& p, int g, int half, char* lds);
__device__ void prep_phase(const Params& p, int bid, int nblk, float* tile) {
  char* ws = p.ws;
  const int tid = threadIdx.x;
  int wb = bid, nwb = nblk;
  const bool split = (nblk >= 128), s5blk = split && bid < 64;
  if (split) { if (s5blk) { prep_s5_group(p, bid >> 1, bid & 1, (char*)tile); return; } wb = bid - 64; nwb = nblk - 64; }
  else { for (int j = bid; j < 64; j += nblk) prep_s5_group(p, j >> 1, j & 1, (char*)tile); }
  const int T_IN = 32 * 16, T_UQ = 12 * 4, T_UKV = 16 * 2, T_GLU = 8 * 8, T_OUT = 16 * 16;
  const int TT = T_IN + T_UQ + T_UKV + T_GLU + T_OUT;
  for (int j = wb; j < TT; j += nwb) {
    int t = j;
    if (t < T_IN) { transpose_tile(p.w_in, DIN, p.pre_g, p.pre_g, 1 << 30, (bf16_t*)(ws + WS_WIN), DM, (t % 32) * 64, (t / 32) * 64, tile, true); continue; }
    t -= T_IN;
    if (t < T_UQ) { transpose_tile(p.w_uq, 768, p.q_g, p.q_g, 1 << 30, (bf16_t*)(ws + WS_WUQ), 256, (t % 12) * 64, (t / 12) * 64, tile); continue; }
    t -= T_UQ;
    if (t < T_UKV) { transpose_tile(p.w_ukv, 1024, p.kv_g, p.kv_g, 1 << 30, (bf16_t*)(ws + WS_WUKV), 128, (t % 16) * 64, (t / 16) * 64, tile); continue; }
    t -= T_UKV;
    if (t < T_GLU) { transpose_tile(p.w_glu, 512, nullptr, nullptr, 0, (bf16_t*)(ws + WS_WGLU), 512, (t % 8) * 64, (t / 8) * 64, tile); continue; }
    t -= T_GLU;
    transpose_tile(p.w_out, 1024, p.ao_g, p.so_g, 512, (bf16_t*)(ws + WS_WOUT), 1024, (t % 16) * 64, (t / 16) * 64, tile);
  }
  {
    float* rope = (float*)(ws + WS_ROPE);
    const int c = tid & 31;
    const float inv = powf(10000.f, -(float)(2 * c) / 64.f);
    const size_t stride = (size_t)nwb * 512;
    for (size_t i0 = (size_t)wb * 512 + tid; i0 < (size_t)NTOK * 32; i0 += 4 * stride) {
      int ps[4];
#pragma unroll
      for (int u = 0; u < 4; ++u) { const size_t i = i0 + u * stride; ps[u] = (i < (size_t)NTOK * 32) ? p.pos[i >> 5] : 0; }
#pragma unroll
      for (int u = 0; u < 4; ++u) { const size_t i = i0 + u * stride;
        if (i < (size_t)NTOK * 32) { const float ang = (float)ps[u] * inv; const double a = (double)ang, k = rint(a * 0.15915494309189535);
          const float r = (float)(a - k * 6.283185307179586); *(f32x2*)(rope + i * 2) = (f32x2){cosf(r), sinf(r)}; } }
    }
  }
  if (nblk == 256) prep_xconv(p, (bid >> 3) - 8, 1, 24, bid & 7);
  else prep_xconv(p, wb, 1, nwb, -1);
}

__device__ void prep_s5_group(const Params& p, int g, int half, char* lds) {
  f32x2* pw = (f32x2*)lds;
  f32x2* bb = (f32x2*)(lds + 17408);
  float* kt = (float*)(lds + 17408 + 16384);
  f32x2* cc = (f32x2*)(lds + 17408 + 16384 + 32768);
  const int tid = threadIdx.x, nt = blockDim.x;
  f32x2* cf = (f32x2*)(lds + 17408 + 16384 + 32768 + 16384);
  for (int i = tid; i < 128; i += nt) {
    const int dir = i >> 6, pp = i & 63;
    const double lr = (double)fminf(p.lam_re[(dir * SG + g) * SP + pp], -1e-4f), li = (double)p.lam_im[(dir * SG + g) * SP + pp];
    const double dt = exp((double)p.log_dt[dir * SG + g]);
    const double zr = lr * dt, zi = li * dt, er = exp(zr), br_ = er * cos(zi), bi_ = er * sin(zi);
    double wr = 1.0, wi = 0.0;
    for (int t = 0; t <= 16; ++t) { pw[i * 17 + t] = (f32x2){(float)wr, (float)wi}; const double nr = wr * br_ - wi * bi_, ni = wr * bi_ + wi * br_; wr = nr; wi = ni; }
    const double ar = br_ - 1.0, ai = bi_, den = lr * lr + li * li;
    cf[i] = (f32x2){(float)((ar * lr + ai * li) / den), (float)((ai * lr - ar * li) / den)};
  }
  __syncthreads();
  for (int i = tid; i < 128 * 16; i += nt) {
    const int dp = i >> 4, h = i & 15, dir = dp >> 6, pp = dp & 63;
    const f32x2 c = cf[dp];
    const float br = p.b_re[((dir * SG + g) * SP + pp) * SH + h], bi = p.b_im[((dir * SG + g) * SP + pp) * SH + h];
    bb[i] = (f32x2){c[0] * br - c[1] * bi, c[0] * bi + c[1] * br};
  }
  for (int i = tid; i < 2048; i += nt) { const int dir = i >> 10, h = (i >> 6) & 15, pp = i & 63;
    cc[i] = (f32x2){p.c_re[((dir * SG + g) * SH + h) * SP + pp], p.c_im[((dir * SG + g) * SH + h) * SP + pp]}; }
  __syncthreads();
  if (half == 0)
  for (int i = tid; i < 512; i += nt) {
    const int dir = i >> 8, tau = (i >> 4) & 15, h = i & 15;
    float s[16];
#pragma unroll
    for (int h2 = 0; h2 < 16; ++h2) s[h2] = 0.f;
    for (int pp = 0; pp < 64; ++pp) {
      const f32x2 c = cc[(dir * 16 + h) * 64 + pp], w = pw[(dir * 64 + pp) * 17 + tau];
      const float er = c[0] * w[0] - c[1] * w[1], ei = c[0] * w[1] + c[1] * w[0];
#pragma unroll
      for (int h2 = 0; h2 < 16; ++h2) { const f32x2 b = bb[(dir * 64 + pp) * 16 + h2]; s[h2] += er * b[0] - ei * b[1]; }
    }
#pragma unroll
    for (int h2 = 0; h2 < 16; ++h2) kt[i * 16 + h2] = s[h2];
  }
  __syncthreads();
  bf16_t* P = (bf16_t*)(p.ws + WS_S5P) + (size_t)g * 65536;
  if (half == 1)
  for (int i = tid; i < 65536; i += nt) {
    const int n = i >> 8, k = i & 255, dir = n >> 7, pp = (n & 127) >> 1, ri = n & 1, s = k >> 4, h2 = k & 15;
    const f32x2 w = pw[(dir * 64 + pp) * 17 + (dir ? s : 15 - s)], b = bb[(dir * 64 + pp) * 16 + h2];
    P[i] = f2bf(ri ? (w[0] * b[1] + w[1] * b[0]) : (w[0] * b[0] - w[1] * b[1]));
  }
  bf16_t* MQ = (bf16_t*)(p.ws + WS_S5MQ) + (size_t)g * 131072;
  for (int i = tid; i < 131072; i += nt) {
    const int n = i >> 9, k = i & 511, ii = n >> 4, h = n & 15;
    if ((k < 256) != (half == 0)) continue;
    float v;
    if (k < 256) { const int s = k >> 4, h2 = k & 15;
      if (ii > s) v = kt[((0 * 16 + (ii - s)) * 16 + h) * 16 + h2];
      else if (ii < s) v = kt[((1 * 16 + (s - ii)) * 16 + h) * 16 + h2];
      else v = kt[((0 * 16 + 0) * 16 + h) * 16 + h2] + kt[((1 * 16 + 0) * 16 + h) * 16 + h2];
    } else { const int kk = k - 256, dir = kk >> 7, pp = (kk & 127) >> 1, ri = kk & 1;
      const f32x2 c = cc[(dir * 16 + h) * 64 + pp], w = pw[(dir * 64 + pp) * 17 + (dir ? 16 - ii : ii + 1)];
      v = ri ? -(c[0] * w[1] + c[1] * w[0]) : (c[0] * w[0] - c[1] * w[1]);
    }
    MQ[i] = f2bf(v);
  }
  f32x2* LT = (f32x2*)(p.ws + WS_S5LT) + g * 128;
  if (half == 1) for (int i = tid; i < 128; i += nt) LT[i] = pw[i * 17 + 16];
  __syncthreads();
}

__device__ void prep_xconv(const Params& p, int slot0, int myslots, int nslot, int xcd) {
  char* ws = p.ws;
  const int tid = opaque(threadIdx.x);

    bf16_t* xb = (bf16_t*)(ws + WS_XB); float* rsx = (float*)(ws + WS_RSX);
    const int lane = tid & 63, w = tid >> 6;
#pragma unroll 1
    for (int sl = 0; sl < myslots; ++sl)
#pragma unroll 1
    for (int v0 = ((slot0 + sl) * 8 + w) * 4; v0 < (xcd >= 0 ? NTOK / 8 : NTOK); v0 += nslot * 8 * 4) {
      const int tv = v0 >> 8, itv = tv >> 5, rest = tv & 31;
      const int r0 = xcd >= 0 ? ((32 * xcd + 4 * (7 - (tv >> 2)) + (tv & 3)) << 8) + (v0 & 255) : ((32 * (rest >> 2) + 4 * (7 - itv) + (rest & 3)) << 8) + (v0 & 255);
      f32x4 v[4][4];
#pragma unroll
      for (int u = 0; u < 4; ++u)
#pragma unroll
        for (int i = 0; i < 4; ++i) v[u][i] = __builtin_nontemporal_load((const f32x4*)(p.x + (size_t)(r0 + u) * DM + i * 256 + lane * 4));
#pragma unroll
      for (int u = 0; u < 4; ++u) {
        float s = 0.f;
#pragma unroll
        for (int i = 0; i < 4; ++i) s += v[u][i][0] * v[u][i][0] + v[u][i][1] * v[u][i][1] + v[u][i][2] * v[u][i][2] + v[u][i][3] * v[u][i][3];
#pragma unroll
        for (int o = 32; o > 0; o >>= 1) s += __shfl_xor(s, o);
        if (lane == 0) rsx[r0 + u] = rsqrtf(s * (1.f / DM) + EPS);
      }
#pragma unroll
      for (int u = 0; u < 4; u += 2) {
        const bool odd = lane & 1;
#pragma unroll
        for (int i = 0; i < 4; ++i) {
          const unsigned a0 = pack2(v[u][i][0], v[u][i][1]), a1 = pack2(v[u][i][2], v[u][i][3]), b0 = pack2(v[u + 1][i][0], v[u + 1][i][1]), b1 = pack2(v[u + 1][i][2], v[u + 1][i][3]);
          const unsigned r0x = __shfl_xor(odd ? a0 : b0, 1), r1x = __shfl_xor(odd ? a1 : b1, 1);
          const u32x4 o4 = odd ? (u32x4){r0x, r1x, b0, b1} : (u32x4){a0, a1, r0x, r1x};
          const int row = r0 + u + (odd ? 1 : 0), col = i * 256 + (lane & ~1) * 4;
          *(u32x4*)(xb + (size_t)((row >> 8) * 32 + (col >> 5)) * 8192 + (size_t)(row & 255) * 32 + (col & 31)) = o4;
        }
      }
    }
}

constexpr int GEMM_LDS = 131072;
#define LDS_BARRIER() do { asm volatile("s_waitcnt lgkmcnt(0)" ::: "memory"); __builtin_amdgcn_s_barrier(); } while (0)
__device__ __forceinline__ int lds_off(int row, int chunk) { return row * 128 + ((chunk ^ ((row >> 1) & 7)) << 4); }

struct GemmRegs { u32x4 ra[4], rb[4]; };
struct GNext { const bf16_t* A; int lda; size_t gs, kts; const bf16_t* B; int ldb; size_t ktsB; int krot, nk; };
__device__ __forceinline__ void gemm256(const bf16_t* __restrict__ A1, int lda1, size_t gs1, size_t ktsA1, int nk1, const bf16_t* __restrict__ A2, int lda2, size_t gs2, size_t ktsA2, int nk2,
                                        const bf16_t* __restrict__ Bt, int ldb, size_t ktsB, char* lds, f32x16 (&acc)[2][4], GemmRegs& G, bool pre, int krot = 0, bool keep_acc = false) {
  const int tid = opaque(threadIdx.x), lane = tid & 63, w = tid >> 6, wm = w >> 2, wn = w & 3, l31 = lane & 31, hi = lane >> 5;
  const int srow = tid >> 3, sch = tid & 7, nk = nk1 + nk2;
  if (!keep_acc) {
#pragma unroll
    for (int nt = 0; nt < 2; ++nt)
#pragma unroll
      for (int mt = 0; mt < 4; ++mt)
#pragma unroll
        for (int r = 0; r < 16; ++r) acc[nt][mt][r] = 0.f;
  }
  const int soff = lds_off(srow, sch);
  const int xoff = (128 * wm + l31) * 128, woff = 32768 + (64 * wn + l31) * 128, swz = (l31 >> 1) & 7;
#define GLOAD(kt) do { const int kq = krot ? (((kt) + krot) & (nk - 1)) : (kt); const bf16_t* Ap; int lda; if (kq < nk1) { Ap = A1 + (size_t)kq * ktsA1 + (sch >> 1) * gs1; lda = lda1; } else { Ap = A2 + (size_t)(kq - nk1) * ktsA2 + (sch >> 1) * gs2; lda = lda2; } \
    _Pragma("unroll") for (int i = 0; i < 4; ++i) G.ra[i] = *(const u32x4*)(Ap + (size_t)(srow + 64 * i) * lda + (sch & 1) * 8); \
    _Pragma("unroll") for (int i = 0; i < 4; ++i) G.rb[i] = *(const u32x4*)(Bt + (size_t)(srow + 64 * i) * ldb + (size_t)kq * ktsB + sch * 8); } while (0)
#define SWRITE(st) do { char* base = lds + (st) * 65536 + soff; \
    _Pragma("unroll") for (int i = 0; i < 4; ++i) { *(u32x4*)(base + 8192 * i) = G.ra[i]; *(u32x4*)(base + 32768 + 8192 * i) = G.rb[i]; } } while (0)
  if (!pre) GLOAD(0);
  SWRITE(0); __syncthreads();
#pragma unroll 1
  for (int kt = 0; kt < nk; ++kt) {
    if (kt + 1 < nk) GLOAD(kt + 1);;
    const char* sb = lds + (kt & 1) * 65536;
#pragma unroll
    for (int ks = 0; ks < 4; ++ks) {
      const int co = ((2 * ks + hi) ^ swz) << 4;
      bf16x8 xf[4], wf[2];
#pragma unroll
      for (int mt = 0; mt < 4; ++mt) xf[mt] = *(const bf16x8*)(sb + xoff + mt * 4096 + co);
#pragma unroll
      for (int nt = 0; nt < 2; ++nt) wf[nt] = *(const bf16x8*)(sb + woff + nt * 4096 + co);
#pragma unroll
      for (int nt = 0; nt < 2; ++nt)
#pragma unroll
        for (int mt = 0; mt < 4; ++mt) acc[nt][mt] = __builtin_amdgcn_mfma_f32_32x32x16_bf16(wf[nt], xf[mt], acc[nt][mt], 0, 0, 0);
    }
    if (kt + 1 < nk) SWRITE((kt + 1) & 1);
    __syncthreads();
  }
#undef GLOAD
#undef SWRITE
}

__device__ __forceinline__ void dma16g(const void* gsrc, unsigned lds_dst) {
  unsigned keep;
  asm volatile("s_mov_b32 %0, m0\n\ts_mov_b32 m0, %2\n\ts_nop 0\n\tglobal_load_lds_dwordx4 %1, off\n\ts_mov_b32 m0, %0" : "=&s"(keep) : "v"(gsrc), "s"(lds_dst) : "memory");
}
__device__ __forceinline__ void gemm256_dma(const bf16_t* __restrict__ A1, int lda1, size_t gs1, size_t ktsA1, int nk1, const bf16_t* __restrict__ A2, int lda2, size_t gs2, size_t ktsA2, int nk2,
                                        const bf16_t* __restrict__ Bt, int ldb, size_t ktsB, char* lds, f32x16 (&acc)[2][4], int krot = 0, bool keep_acc = false, const float* resc = nullptr, size_t hsA = 32, size_t hsB = 32) {
  const int tid = opaque(threadIdx.x), lane = tid & 63, w = __builtin_amdgcn_readfirstlane(tid >> 6), wm = w >> 2, wn = w & 3, l31 = lane & 31, hi = lane >> 5;
  const int nk = nk1 + nk2, ns = 2 * nk;
  if (!keep_acc) {
#pragma unroll
    for (int nt = 0; nt < 2; ++nt)
#pragma unroll
      for (int mt = 0; mt < 4; ++mt)
#pragma unroll
        for (int r = 0; r < 16; ++r) acc[nt][mt][r] = 0.f;
  }
  const int rb0 = 16 * w + (lane >> 2), rb1 = 16 * (w + 8) + (lane >> 2);
  const int c0 = (lane & 3) ^ ((rb0 >> 2) & 3), c1 = (lane & 3) ^ ((rb1 >> 2) & 3);
  const unsigned ldsb = (unsigned)(uintptr_t)lds;
#define DMA_STEP(st_) do { const int st__ = (st_), t64 = st__ >> 1, hf = st__ & 1, kq = krot ? (resc ? ((t64 & (nk >> 1)) | ((t64 + krot) & ((nk >> 1) - 1))) : ((t64 + krot) & (nk - 1))) : t64; \
    const bf16_t* Ap; int lda; size_t gs; if (kq < nk1) { Ap = A1 + (size_t)kq * ktsA1; lda = lda1; gs = gs1; } else { Ap = A2 + (size_t)(kq - nk1) * ktsA2; lda = lda2; gs = gs2; } \
    const unsigned sb_ = ldsb + (st__ & 3) * 32768; \
    dma16g(Ap + (size_t)rb0 * lda + (size_t)hf * hsA + (size_t)(c0 >> 1) * gs + (c0 & 1) * 8, __builtin_amdgcn_readfirstlane(sb_ + w * 1024)); \
    dma16g(Ap + (size_t)rb1 * lda + (size_t)hf * hsA + (size_t)(c1 >> 1) * gs + (c1 & 1) * 8, __builtin_amdgcn_readfirstlane(sb_ + (w + 8) * 1024)); \
    const bf16_t* Bp = Bt + (size_t)kq * ktsB + hf * hsB; \
    dma16g(Bp + (size_t)rb0 * ldb + c0 * 8, __builtin_amdgcn_readfirstlane(sb_ + 16384 + w * 1024)); \
    dma16g(Bp + (size_t)rb1 * ldb + c1 * 8, __builtin_amdgcn_readfirstlane(sb_ + 16384 + (w + 8) * 1024)); } while (0)
  const int xoff = (128 * wm + l31) * 64, woff = 16384 + (64 * wn + l31) * 64, swz = (l31 >> 2) & 3;
  DMA_STEP(0); DMA_STEP(1); DMA_STEP(2);
#define DMA_SETUP(st_) const int st3_ = (st_), t64_ = st3_ >> 1, hf_ = st3_ & 1, kq_ = krot ? (resc ? ((t64_ & (nk >> 1)) | ((t64_ + krot) & ((nk >> 1) - 1))) : ((t64_ + krot) & (nk - 1))) : t64_; \
    const bf16_t* Ap_; int lda_; size_t gs_; if (kq_ < nk1) { Ap_ = A1 + (size_t)kq_ * ktsA1; lda_ = lda1; gs_ = gs1; } else { Ap_ = A2 + (size_t)(kq_ - nk1) * ktsA2; lda_ = lda2; gs_ = gs2; } \
    const unsigned sb3_ = ldsb + (st3_ & 3) * 32768; const bf16_t* Bp_ = Bt + (size_t)kq_ * ktsB + hf_ * hsB;
#define DMA_PIECE(q) do { if (more) { \
    if ((q) == 0) dma16g(Ap_ + (size_t)rb0 * lda_ + (size_t)hf_ * hsA + (size_t)(c0 >> 1) * gs_ + (c0 & 1) * 8, __builtin_amdgcn_readfirstlane(sb3_ + w * 1024)); \
    if ((q) == 1) dma16g(Ap_ + (size_t)rb1 * lda_ + (size_t)hf_ * hsA + (size_t)(c1 >> 1) * gs_ + (c1 & 1) * 8, __builtin_amdgcn_readfirstlane(sb3_ + (w + 8) * 1024)); \
    if ((q) == 2) dma16g(Bp_ + (size_t)rb0 * ldb + c0 * 8, __builtin_amdgcn_readfirstlane(sb3_ + 16384 + w * 1024)); \
    if ((q) == 3) dma16g(Bp_ + (size_t)rb1 * ldb + c1 * 8, __builtin_amdgcn_readfirstlane(sb3_ + 16384 + (w + 8) * 1024)); } } while (0)
#define MMA4(WF, XF, NT) do { _Pragma("unroll") for (int mt = 0; mt < 4; ++mt) acc[NT][mt] = __builtin_amdgcn_mfma_f32_32x32x16_bf16(WF[NT], XF[mt], acc[NT][mt], 0, 0, 0); } while (0)
#pragma unroll 1
  for (int st = 0; st < ns; ++st) {
    if (st + 2 < ns) asm volatile("s_waitcnt vmcnt(8)" ::: "memory"); else if (st + 1 < ns) asm volatile("s_waitcnt vmcnt(4)" ::: "memory"); else asm volatile("s_waitcnt vmcnt(0)" ::: "memory");
    __builtin_amdgcn_s_barrier();
    const bool more = st + 3 < ns;
    DMA_SETUP(st + 3)
    if (resc && st == (ns >> 1)) {
#pragma unroll
      for (int nt = 0; nt < 2; ++nt)
#pragma unroll
        for (int mt = 0; mt < 4; ++mt)
#pragma unroll
          for (int r = 0; r < 16; ++r) acc[nt][mt][r] *= resc[mt];
    }
    const char* sb = lds + (st & 3) * 32768;
    const int coA = ((0 + hi) ^ swz) << 4, coB = ((2 + hi) ^ swz) << 4;
    bf16x8 xf0[4], wf0[2], xf1[4], wf1[2];
#pragma unroll
    for (int mt = 0; mt < 4; ++mt) xf0[mt] = *(const bf16x8*)(sb + xoff + mt * 2048 + coA);
#pragma unroll
    for (int nt = 0; nt < 2; ++nt) wf0[nt] = *(const bf16x8*)(sb + woff + nt * 2048 + coA);
    MMA4(wf0, xf0, 0);
    __builtin_amdgcn_sched_barrier(0); DMA_PIECE(0); __builtin_amdgcn_sched_barrier(0);
#pragma unroll
    for (int mt = 0; mt < 4; ++mt) xf1[mt] = *(const bf16x8*)(sb + xoff + mt * 2048 + coB);
#pragma unroll
    for (int nt = 0; nt < 2; ++nt) wf1[nt] = *(const bf16x8*)(sb + woff + nt * 2048 + coB);
    MMA4(wf0, xf0, 1);
    __builtin_amdgcn_sched_barrier(0); DMA_PIECE(1); __builtin_amdgcn_sched_barrier(0);
    MMA4(wf1, xf1, 0);
    __builtin_amdgcn_sched_barrier(0); DMA_PIECE(2); __builtin_amdgcn_sched_barrier(0);
    MMA4(wf1, xf1, 1);
    __builtin_amdgcn_sched_barrier(0); DMA_PIECE(3); __builtin_amdgcn_sched_barrier(0);
    asm volatile("s_waitcnt lgkmcnt(0)" ::: "memory");
  }
#undef DMA_SETUP
#undef DMA_PIECE
#undef MMA4
#undef DMA_STEP
  __syncthreads();
}

__device__ __forceinline__ void gemm_preload(const GNext nxt, GemmRegs& G) {
  if (!nxt.A) return;
  const int tid = opaque(threadIdx.x), srow = tid >> 3, sch = tid & 7;
  const int kq = nxt.krot ? (nxt.krot & (nxt.nk - 1)) : 0;
  const bf16_t* Ap = nxt.A + (size_t)kq * nxt.kts + (sch >> 1) * nxt.gs;
#pragma unroll
  for (int i = 0; i < 4; ++i) G.ra[i] = *(const u32x4*)(Ap + (size_t)(srow + 64 * i) * nxt.lda + (sch & 1) * 8);
#pragma unroll
  for (int i = 0; i < 4; ++i) G.rb[i] = *(const u32x4*)(nxt.B + (size_t)(srow + 64 * i) * nxt.ldb + (size_t)kq * nxt.ktsB + sch * 8);
}

__device__ __forceinline__ void tile_put(char* lds, int row, int col, unsigned w0, unsigned w1) {
  const u32x2 v = {w0, w1};
  *(u32x2*)(lds + row * 512 + ((((col >> 3) ^ row) & 31) << 4) + ((col & 7) << 1)) = v;
}
__device__ __forceinline__ u32x4 tile_get(const char* lds, int row, int chunk) { return *(const u32x4*)(lds + row * 512 + (((chunk ^ row) & 31) << 4)); }
__device__ __forceinline__ void st16(bf16_t* d, u32x4 v, bool nt) {
  if (nt) __builtin_nontemporal_store(v, (u32x4*)d);
  else *(u32x4*)d = v;
}
__device__ __forceinline__ void tile_out(const char* lds, bf16_t* base, size_t ld, int nrep, size_t rstride, bool wt = false) {
  const int tid = threadIdx.x, chunk = tid & 31, r0 = tid >> 5;
#pragma unroll 1
  for (int hb = 0; hb < 2; ++hb) {
    u32x4 v[8];
#pragma unroll
    for (int i = 0; i < 8; ++i) v[i] = tile_get(lds, r0 + 16 * (8 * hb + i), chunk);
#pragma unroll
    for (int i = 0; i < 8; ++i) {
      bf16_t* d = base + (size_t)(r0 + 16 * (8 * hb + i)) * ld;
      st16(d, v[i], wt);
      if (nrep > 1) { st16(d + rstride, v[i], wt); st16(d + 2 * rstride, v[i], wt); st16(d + 3 * rstride, v[i], wt); }
    }
  }
}
#ifndef WT_STORES
#define WT_STORES 0
#endif
constexpr int LX_RSX = GEMM_LDS, LX_SSQ = GEMM_LDS + 1024  , LX_SSKV = GEMM_LDS + 5120  , LX_END = GEMM_LDS + 7168;

__device__ __forceinline__ int crow(int r, int hi) { return (r & 3) + 8 * (r >> 2) + 4 * hi; }

__device__ void phase1_win(const Params& p, int mtile, int ntile, char* lds, int krot) {
  char* ws = p.ws;
  const int tid = threadIdx.x;
  const int m0 = mtile * 256, bat = m0 / SEQ, s0 = m0 % SEQ;
  float* rsx = (float*)(lds + LX_RSX); float* ssq = (float*)(lds + LX_SSQ); float* sskv = (float*)(lds + LX_SSKV);
  bf16_t* xb = (bf16_t*)(ws + WS_XB); bf16_t* zq = (bf16_t*)(ws + WS_ZQ); bf16_t* zkv = (bf16_t*)(ws + WS_ZKV);
  bf16_t* gat = (bf16_t*)(ws + WS_GAT); bf16_t* gss = (bf16_t*)(ws + WS_GSS); bf16_t* us = (bf16_t*)(ws + WS_US);
  bf16_t* Q = (bf16_t*)(ws + WS_Q); bf16_t* Kf = (bf16_t*)(ws + WS_K); bf16_t* V = (bf16_t*)(ws + WS_V);
  const float* rope = (const float*)(ws + WS_ROPE);
  { const int tp = opaque(tid); if (tp < 256) rsx[tp] = ((const float*)(ws + WS_RSX))[m0 + tp]; }
  __syncthreads();
  f32x16 acc[2][4];
  {
    const int n0 = ntile * 256;
    gemm256_dma(xb + (size_t)mtile * 16 * 16384, 32, 16, 16384, 16, xb, 32, 16, 16384, 0, (const bf16_t*)(ws + WS_WIN) + (size_t)ntile * 16 * 16384, 32, 16384, lds, acc, krot, false, nullptr, 8192, 8192);
    {
      const int tid_o = opaque(threadIdx.x), lane_o = tid_o & 63, l31 = lane_o & 31, hi = lane_o >> 5, w = tid_o >> 6, wm = w >> 2, wn = w & 3;
      const int cb = n0 + 64 * wn;
      if (cb == C_ZKR) {
#pragma unroll
        for (int mt = 0; mt < 4; ++mt) {
          const int rl = 128 * wm + 32 * mt + l31;
          const float rs = rsx[rl];
          const float* rp = rope + ((size_t)(m0 + rl) * 32 + 4 * hi) * 2;
#pragma unroll
          for (int q = 0; q < 4; ++q) {
            const f32x4 t0 = *(const f32x4*)(rp + 16 * q), t1 = *(const f32x4*)(rp + 16 * q + 4);
            const float cs[4] = {t0[0], t0[2], t1[0], t1[2]}, sn[4] = {t0[1], t0[3], t1[1], t1[3]};
            float o1[4], o2[4];
#pragma unroll
            for (int e = 0; e < 4; ++e) { const float a = acc[0][mt][4 * q + e] * rs, bb = acc[1][mt][4 * q + e] * rs; o1[e] = a * cs[e] - bb * sn[e]; o2[e] = a * sn[e] + bb * cs[e]; }
            tile_put(lds, rl, 64 * wn + 8 * q + 4 * hi, pack2(o1[0], o1[1]), pack2(o1[2], o1[3]));
            tile_put(lds, rl, 64 * wn + 32 + 8 * q + 4 * hi, pack2(o2[0], o2[1]), pack2(o2[2], o2[3]));
          }
          __builtin_amdgcn_sched_barrier(0);
        }
      } else if (cb < C_ZKR) {
#pragma unroll
        for (int mt = 0; mt < 4; ++mt) {
          const int rl = 128 * wm + 32 * mt + l31;
          const float rs = rsx[rl];
          float sq = 0.f;
#pragma unroll
          for (int nt = 0; nt < 2; ++nt)
#pragma unroll
            for (int q = 0; q < 4; ++q) {
              float v[4];
#pragma unroll
              for (int e = 0; e < 4; ++e) { v[e] = acc[nt][mt][4 * q + e] * rs; sq += v[e] * v[e]; }
              tile_put(lds, rl, 64 * wn + 32 * nt + 8 * q + 4 * hi, pack2(v[0], v[1]), pack2(v[2], v[3]));
            }
          sq += __shfl_xor(sq, 32);
          if (hi == 0) { if (cb < C_ZKV) ssq[wn * 256 + rl] = sq; else sskv[wn * 256 + rl] = sq; }
          __builtin_amdgcn_sched_barrier(0);
        }
      } else if (cb < DIN) {
        const bool gate = !(cb >= C_US && cb < C_GS);
#pragma unroll
        for (int mt = 0; mt < 4; ++mt) {
          const int rl = 128 * wm + 32 * mt + l31;
          const float rs = rsx[rl];
#pragma unroll
          for (int nt = 0; nt < 2; ++nt)
#pragma unroll
            for (int q = 0; q < 4; ++q) {
              float v[4];
#pragma unroll
              for (int e = 0; e < 4; ++e) { v[e] = acc[nt][mt][4 * q + e] * rs; if (gate) v[e] = silu_f(v[e]); }
              tile_put(lds, rl, 64 * wn + 32 * nt + 8 * q + 4 * hi, pack2(v[0], v[1]), pack2(v[2], v[3]));
            }
          __builtin_amdgcn_sched_barrier(0);
        }
      }
    }
    __syncthreads();
    {
      const int col = n0 + (opaque(tid) & 31) * 8;
      bf16_t* base = nullptr; size_t ld = 0; int nrep = 1;
      if (col < C_ZKV) { base = zq + (size_t)m0 * 256 + col; ld = 256; }
      else if (col < C_ZKR) { base = zkv + (size_t)m0 * 128 + (col - C_ZKV); ld = 128; }
      else if (col < C_GA) { base = Kf + (((size_t)bat * NH) * SEQ + s0) * DQK + 128 + (col - C_ZKR); ld = DQK; nrep = 4; }
      else if (col < C_US) { base = gat + (size_t)m0 * 512 + (col - C_GA); ld = 512; }
      else if (col < C_GS) { const int cc = col - C_US; base = us + ((size_t)(cc >> 4) * NTOK + m0) * 16 + (cc & 15); ld = 16; }
      else if (col < DIN) { const int cc = col - C_GS; base = gss + ((size_t)(cc >> 4) * NTOK + m0) * 16 + (cc & 15); ld = 16; }
      if (base) tile_out(lds, base, ld, nrep, (size_t)SEQ * DQK, (col >= C_GA && col < C_US) || col >= C_GS);
    }
    __syncthreads();
  }
}

__device__ void phase1_up(const Params& p, int mtile, int which, char* lds, bool partials) {
  GemmRegs G;
  char* ws = p.ws;
  const int tid = threadIdx.x, lane = tid & 63, w = tid >> 6, wm = w >> 2, wn = w & 3;
  const int m0 = mtile * 256, bat = m0 / SEQ, s0 = m0 % SEQ;
  float* ssqp = (float*)(lds + LX_SSQ); float* sskp = (float*)(lds + LX_SSKV); float* ssq = (float*)(lds + LX_END); float* sskv = (float*)(lds + LX_END + 1024);
  bf16_t* zq = (bf16_t*)(ws + WS_ZQ); bf16_t* zkv = (bf16_t*)(ws + WS_ZKV);
  bf16_t* Q = (bf16_t*)(ws + WS_Q); bf16_t* Kf = (bf16_t*)(ws + WS_K); bf16_t* V = (bf16_t*)(ws + WS_V);
  const float* rope = (const float*)(ws + WS_ROPE);
  if (partials) { const int tp = opaque(tid); if (tp < 256) { ssq[tp] = ssqp[tp] + ssqp[256 + tp] + ssqp[512 + tp] + ssqp[768 + tp]; sskv[tp] = sskp[tp] + sskp[256 + tp]; } }
  else {
    const int lane_s = opaque(lane);
#pragma unroll 1
    for (int rr = 0; rr < 32; rr += 8) {
      u32x2 a[8]; unsigned b[8];
#pragma unroll
      for (int u = 0; u < 8; ++u) { const size_t row = m0 + w * 32 + rr + u; a[u] = *(const u32x2*)(zq + row * 256 + lane_s * 4); b[u] = *(const unsigned*)(zkv + row * 128 + lane_s * 2); }
#pragma unroll
      for (int u = 0; u < 8; ++u) {
        const float q0 = __uint_as_float(a[u][0] << 16), q1 = __uint_as_float(a[u][0] & 0xffff0000u), q2 = __uint_as_float(a[u][1] << 16), q3 = __uint_as_float(a[u][1] & 0xffff0000u);
        const float k0 = __uint_as_float(b[u] << 16), k1 = __uint_as_float(b[u] & 0xffff0000u);
        float sq = q0 * q0 + q1 * q1 + q2 * q2 + q3 * q3, sk = k0 * k0 + k1 * k1;
#pragma unroll
        for (int o = 32; o > 0; o >>= 1) { sq += __shfl_xor(sq, o); sk += __shfl_xor(sk, o); }
        if (lane == 0) { ssq[w * 32 + rr + u] = sq; sskv[w * 32 + rr + u] = sk; }
      }
    }
  }
  __syncthreads();
  f32x16 acc[2][4];
  if (which & 1) {
#pragma unroll 1
    for (int ntile = 0; ntile < 3; ++ntile) {
      const int n0 = ntile * 256;
      const bf16_t* wuq = (const bf16_t*)(ws + WS_WUQ);
      const GNext nx = (ntile < 2) ? GNext{zq + (size_t)m0 * 256, 256, 16, 64, wuq + (size_t)(n0 + 256) * 256, 256, 64, 0, 4}
                     : ((which & 2) ? GNext{zkv + (size_t)m0 * 128, 128, 16, 64, (const bf16_t*)(ws + WS_WUKV), 128, 64, 0, 2} : GNext{nullptr, 0, 0, 0, nullptr, 0, 0, 0, 0});
      gemm256(zq + (size_t)m0 * 256, 256, 16, 64, 4, zq, 256, 16, 64, 0, wuq + (size_t)n0 * 256, 256, 64, lds, acc, G, ntile > 0);
      {
        const int lane_o = opaque(lane), l31 = lane_o & 31, hi = lane_o >> 5;
        const int cb = n0 + 64 * wn, d0 = cb % DQK;
#pragma unroll
        for (int mt = 0; mt < 4; ++mt) {
          const int rl = 128 * wm + 32 * mt + l31;
          const float rs = rsqrtf(ssq[rl] * (1.f / 256.f) + EPS);
          if (d0 == 128) {
            const float* rp = rope + ((size_t)(m0 + rl) * 32 + 4 * hi) * 2;
#pragma unroll
            for (int q = 0; q < 4; ++q) {
              const f32x4 t0 = *(const f32x4*)(rp + 16 * q), t1 = *(const f32x4*)(rp + 16 * q + 4);
              const float cs[4] = {t0[0], t0[2], t1[0], t1[2]}, sn[4] = {t0[1], t0[3], t1[1], t1[3]};
              float o1[4], o2[4];
#pragma unroll
              for (int e = 0; e < 4; ++e) { const float a = acc[0][mt][4 * q + e] * rs, bb = acc[1][mt][4 * q + e] * rs; o1[e] = a * cs[e] - bb * sn[e]; o2[e] = a * sn[e] + bb * cs[e]; }
              tile_put(lds, rl, 64 * wn + 8 * q + 4 * hi, pack2(o1[0], o1[1]), pack2(o1[2], o1[3]));
              tile_put(lds, rl, 64 * wn + 32 + 8 * q + 4 * hi, pack2(o2[0], o2[1]), pack2(o2[2], o2[3]));
            }
          } else {
#pragma unroll
            for (int nt = 0; nt < 2; ++nt)
#pragma unroll
              for (int q = 0; q < 4; ++q)
                tile_put(lds, rl, 64 * wn + 32 * nt + 8 * q + 4 * hi, pack2(acc[nt][mt][4 * q] * rs, acc[nt][mt][4 * q + 1] * rs), pack2(acc[nt][mt][4 * q + 2] * rs, acc[nt][mt][4 * q + 3] * rs));
          }
          __builtin_amdgcn_sched_barrier(0);
        }
      }
      gemm_preload(nx, G);
      __syncthreads();
      { const int col = n0 + (opaque(tid) & 31) * 8, h = col / DQK, d = col % DQK;
        tile_out(lds, Q + (((size_t)bat * NH + h) * SEQ + s0) * DQK + d, DQK, 1, 0, false); }
      __syncthreads();
    }
  }
  if (which & 2) {
#pragma unroll 1
    for (int ntile = 0; ntile < 4; ++ntile) {
      const int n0 = ntile * 256;
      const bf16_t* wukv = (const bf16_t*)(ws + WS_WUKV);
      const GNext nx = (ntile < 3) ? GNext{zkv + (size_t)m0 * 128, 128, 16, 64, wukv + (size_t)(n0 + 256) * 128, 128, 64, 0, 2} : GNext{nullptr, 0, 0, 0, nullptr, 0, 0, 0, 0};
      gemm256(zkv + (size_t)m0 * 128, 128, 16, 64, 2, zkv, 128, 16, 64, 0, wukv + (size_t)n0 * 128, 128, 64, lds, acc, G, ntile > 0 || (which & 1));
      {
        const int lane_o = opaque(lane), l31 = lane_o & 31, hi = lane_o >> 5;
#pragma unroll
        for (int mt = 0; mt < 4; ++mt) {
          const int rl = 128 * wm + 32 * mt + l31;
          const float rs = rsqrtf(sskv[rl] * (1.f / 128.f) + EPS);
#pragma unroll
          for (int nt = 0; nt < 2; ++nt)
#pragma unroll
            for (int q = 0; q < 4; ++q)
              tile_put(lds, rl, 64 * wn + 32 * nt + 8 * q + 4 * hi, pack2(acc[nt][mt][4 * q] * rs, acc[nt][mt][4 * q + 1] * rs), pack2(acc[nt][mt][4 * q + 2] * rs, acc[nt][mt][4 * q + 3] * rs));
          __builtin_amdgcn_sched_barrier(0);
        }
      }
      gemm_preload(nx, G);
      __syncthreads();
      { const int col = n0 + (opaque(tid) & 31) * 8, h = col >> 8, d = col & 255;
        bf16_t* base = (d < 128) ? Kf + (((size_t)bat * NH + h) * SEQ + s0) * DQK + d : V + (((size_t)bat * NH + h) * SEQ + s0) * DV + (d - 128);
        tile_out(lds, base, (d < 128) ? DQK : DV, 1, 0, false); }
      __syncthreads();
    }
  }
  __syncthreads();
}
#ifndef P3_ROT
#define P3_ROT 1
#endif
constexpr int L3_SSA = GEMM_LDS  , L3_SSS = GEMM_LDS + 1024  , L3_SSM = GEMM_LDS + 5120  ;

__device__ void phase3_tile(const Params& p, int mtile, char* lds) {
  GemmRegs G;
  char* ws = p.ws;
  const int tid = threadIdx.x, lane = tid & 63, w = tid >> 6, wm = w >> 2, wn = w & 3;
  const int m0 = mtile * 256;
  float* ssa = (float*)(lds + L3_SSA); float* sss = (float*)(lds + L3_SSS); float* ssm = (float*)(lds + L3_SSM);
  const bf16_t* ys = (const bf16_t*)(ws + WS_YS);
  const bf16_t* gat = (const bf16_t*)(ws + WS_GAT); const bf16_t* gss = (const bf16_t*)(ws + WS_GSS);
  bf16_t* amix = amix_tile(ws, mtile); bf16_t* mixed = mixed_tile(ws, mtile);
  f32x16 acc[2][4];
#pragma unroll 1
  for (int ntile = 0; ntile < 2; ++ntile) {
    const int n0 = ntile * 256;
    const bf16_t* wglu = (const bf16_t*)(ws + WS_WGLU); const bf16_t* wout = (const bf16_t*)(ws + WS_WOUT);
    const int rot3 = P3_ROT ? ((blockIdx.x >> 3) & 7) : 0;
    const GNext nxg = (ntile == 0) ? GNext{ys + (size_t)m0 * 16, 16, (size_t)NTOK * 16, 4 * ((size_t)NTOK * 16), wglu + (size_t)256 * 512, 512, 64, rot3, 8}
                                   : GNext{nullptr, 0, 0, 0, nullptr, 0, 0, 0, 0};
    gemm256(ys + (size_t)m0 * 16, 16, (size_t)NTOK * 16, 4 * ((size_t)NTOK * 16), 8, ys, 16, 16, 64, 0, wglu + (size_t)n0 * 512, 512, 64, lds, acc, G, ntile > 0, rot3);
    {
      const int lane_o = opaque(lane), l31 = lane_o & 31, hi = lane_o >> 5;
      const int cb = n0 + 64 * wn;
#pragma unroll
      for (int mt = 0; mt < 4; ++mt) {
        const int rl = 128 * wm + 32 * mt + l31, row = m0 + rl;
        float sq = 0.f;
#pragma unroll
        for (int nt = 0; nt < 2; ++nt)
#pragma unroll
          for (int q = 0; q < 4; ++q) {
            const int col = cb + 32 * nt + 8 * q + 4 * hi;
            const f32x4 bg = *(const f32x4*)(p.b_glu + col);
            const u32x2 yv = *(const u32x2*)(ys + ((size_t)(col >> 4) * NTOK + row) * 16 + (col & 15));
            const float y[4] = {__uint_as_float(yv[0] << 16), __uint_as_float(yv[0] & 0xffff0000u), __uint_as_float(yv[1] << 16), __uint_as_float(yv[1] & 0xffff0000u)};
            float v[4];
            const u32x2 gv = *(const u32x2*)(gss + ((size_t)(col >> 4) * NTOK + row) * 16 + (col & 15));
            const float gg[4] = {__uint_as_float(gv[0] << 16), __uint_as_float(gv[0] & 0xffff0000u), __uint_as_float(gv[1] << 16), __uint_as_float(gv[1] & 0xffff0000u)};
#pragma unroll
            for (int e = 0; e < 4; ++e) { v[e] = y[e] * sigmoid_f(acc[nt][mt][4 * q + e] + bg[e]); sq += v[e] * v[e]; v[e] *= gg[e]; }
            tile_put(lds, rl, 64 * wn + 32 * nt + 8 * q + 4 * hi, pack2(v[0], v[1]), pack2(v[2], v[3]));
          }
        sq += __shfl_xor(sq, 32);
        if (hi == 0) { if (ntile == 0) sss[wn * 256 + rl] = sq; else sss[wn * 256 + rl] += sq; }
        __builtin_amdgcn_sched_barrier(0);
      }
    }
    gemm_preload(nxg, G);
    __syncthreads();
    tile_out(lds, amix + 512 + n0 + (opaque(tid) & 31) * 8, 1024, 1, 0);
    __syncthreads();
  }
  __syncthreads();
#pragma unroll 1
  for (int ntile = 0; ntile < 4; ++ntile) {
    const int n0 = ntile * 256;
    float resc[4];
    {
      const int lane_r = opaque(lane), l31r = lane_r & 31;
#pragma unroll
      for (int mt = 0; mt < 4; ++mt) {
        const int rl = 128 * wm + 32 * mt + l31r;
        const f32x4 sa = *(const f32x4*)((const float*)(ws + WS_SSA) + (size_t)(m0 + rl) * 4);
        const float ra = rsqrtf((sa[0] + sa[1] + sa[2] + sa[3]) * (1.f / 512.f) + EPS);
        resc[mt] = ra / rsqrtf((sss[rl] + sss[256 + rl] + sss[512 + rl] + sss[768 + rl]) * (1.f / 512.f) + EPS);
      }
    }
    const bf16_t* wout = (const bf16_t*)(ws + WS_WOUT);
    const int rot3 = P3_ROT ? ((blockIdx.x >> 3) & 7) : 0;
    gemm256_dma(amix, 1024, 16, 64, 16, amix, 1024, 16, 64, 0, wout + (size_t)n0 * 1024, 1024, 64, lds, acc, rot3, false, resc);
    {
      const int lane_o = opaque(lane), l31 = lane_o & 31, hi = lane_o >> 5;
#pragma unroll
      for (int mt = 0; mt < 4; ++mt) {
        const int rl = 128 * wm + 32 * mt + l31;
        const float rsv = rsqrtf((sss[rl] + sss[256 + rl] + sss[512 + rl] + sss[768 + rl]) * (1.f / 512.f) + EPS);
        float sq = 0.f;
#pragma unroll
        for (int nt = 0; nt < 2; ++nt)
#pragma unroll
          for (int q = 0; q < 4; ++q) {
            float v[4];
#pragma unroll
            for (int e = 0; e < 4; ++e) { v[e] = acc[nt][mt][4 * q + e] * rsv; sq += v[e] * v[e]; }
            tile_put(lds, rl, 64 * wn + 32 * nt + 8 * q + 4 * hi, pack2(v[0], v[1]), pack2(v[2], v[3]));
          }
        sq += __shfl_xor(sq, 32);
        if (hi == 0) { if (ntile == 0) ssm[wn * 256 + rl] = sq; else ssm[wn * 256 + rl] += sq; }
        __builtin_amdgcn_sched_barrier(0);
      }
    }
    __syncthreads();
    if (ntile < 3) { tile_out(lds, mixed + n0 + (opaque(tid) & 31) * 8, 1024, 1, 0); __syncthreads(); }
  }
  {
    const bf16_t* xb = (const bf16_t*)(ws + WS_XB);
    const int tid_o = opaque(tid), c8 = (tid_o & 127) * 8;
    const f32x4 g0 = *(const f32x4*)(p.post_g + c8), g1 = *(const f32x4*)(p.post_g + c8 + 4);
#pragma unroll 1
    for (int r0 = tid_o >> 7; r0 < 256; r0 += 16) {
      bf16x8 mv[4], xv[4];
#pragma unroll
      for (int u2 = 0; u2 < 4; ++u2) { const size_t row = m0 + r0 + 4 * u2; if (c8 < 768) mv[u2] = *(const bf16x8*)(mixed + (size_t)(r0 + 4 * u2) * 1024 + c8); else { const u32x4 t = tile_get(lds, r0 + 4 * u2, (c8 - 768) >> 3); mv[u2] = *(const bf16x8*)&t; } xv[u2] = __builtin_nontemporal_load((const bf16x8*)(xb + ((size_t)(mtile * 32 + (c8 >> 5)) * 256 + r0 + 4 * u2) * 32 + (c8 & 31))); }
#pragma unroll
      for (int u2 = 0; u2 < 4; ++u2) {
        const int rl = r0 + 4 * u2;
        const float rs = rsqrtf((ssm[rl] + ssm[256 + rl] + ssm[512 + rl] + ssm[768 + rl]) * (1.f / DM) + EPS);
        f32x4 oa, oc;
#pragma unroll
        for (int e = 0; e < 4; ++e) { oa[e] = bf2f((bf16_t)xv[u2][e]) + bf2f((bf16_t)mv[u2][e]) * rs * g0[e]; oc[e] = bf2f((bf16_t)xv[u2][4 + e]) + bf2f((bf16_t)mv[u2][4 + e]) * rs * g1[e]; }
        __builtin_nontemporal_store(oa, (f32x4*)(p.out + (size_t)(m0 + rl) * DM + c8)); __builtin_nontemporal_store(oc, (f32x4*)(p.out + (size_t)(m0 + rl) * DM + c8 + 4));
      }
    }
  }
  __syncthreads();
}
#ifndef ATT_LATE
#define ATT_LATE 1
#endif
#ifndef ATT_ROT
#define ATT_ROT 0
#endif
namespace att {
constexpr int NW = 8, QBLK = 32, KVBLK = 64;
constexpr float SCALE = 0.07216878364870322f;
constexpr float THR = 8.f;
constexpr int SHM_V = KVBLK * DV * 2, SHM_K = KVBLK * DQK * 2, LDS_ATTN = 2 * SHM_V + 2 * SHM_K + NW * 64 * 4;
#define SBAR() __builtin_amdgcn_sched_barrier(0)
__device__ __forceinline__ unsigned cvtpk(float lo, float hi) { unsigned r; asm volatile("v_cvt_pk_bf16_f32 %0, %1, %2" : "=v"(r) : "v"(lo), "v"(hi)); return r; }
__device__ __forceinline__ void dma16(const void* gsrc, unsigned lds_dst) {
  unsigned keep;
  asm volatile("s_mov_b32 %0, m0\n\ts_mov_b32 m0, %2\n\ts_nop 0\n\tglobal_load_lds_dwordx4 %1, off\n\ts_mov_b32 m0, %0" : "=&s"(keep) : "v"(gsrc), "s"(lds_dst) : "memory");
}
__device__ __forceinline__ int koff(int row, int c) { return row * 384 + ((c ^ ((row >> 1) & 7)) << 4); }

__device__ __forceinline__ void partialSM(f32x16& p0, f32x16& p1, float& m_reg, float& mn, float& alpha) {
  constexpr float C = SCALE * 1.4426950408889634f;
  float pmax = p0[0];
#pragma unroll
  for (int r = 1; r < 16; ++r) pmax = fmaxf(pmax, p0[r]);
#pragma unroll
  for (int r = 0; r < 16; ++r) pmax = fmaxf(pmax, p1[r]);
  { auto rr = __builtin_amdgcn_permlane32_swap(__float_as_uint(pmax), __float_as_uint(pmax), false, false);
    pmax = fmaxf(__uint_as_float(rr[0]), __uint_as_float(rr[1])); }
  if (__builtin_expect(__all(pmax - m_reg <= THR / SCALE), 1)) { mn = m_reg; alpha = 1.f; }
  else { mn = fmaxf(m_reg, pmax); alpha = __builtin_amdgcn_exp2f((m_reg - mn) * C); m_reg = mn; }
  const float mnC = -mn * C;
#pragma unroll
  for (int r = 0; r < 16; ++r) p0[r] = fmaf(p0[r], C, mnC);
#pragma unroll
  for (int r = 0; r < 16; ++r) p1[r] = fmaf(p1[r], C, mnC);
#pragma unroll
  for (int r = 0; r < 16; ++r) p0[r] = __builtin_amdgcn_exp2f(p0[r]);
}
__device__ __forceinline__ void finishSM(f32x16& p0, f32x16& p1, float alpha, float& l_reg, bf16x8& pa0, bf16x8& pa1, bf16x8& pa2, bf16x8& pa3) {
#pragma unroll
  for (int r = 0; r < 16; ++r) p1[r] = __builtin_amdgcn_exp2f(p1[r]);
  float ps = 0;
#pragma unroll
  for (int r = 0; r < 16; ++r) ps += p0[r];
#pragma unroll
  for (int r = 0; r < 16; ++r) ps += p1[r];
  { auto rr = __builtin_amdgcn_permlane32_swap(__float_as_uint(ps), __float_as_uint(ps), false, false);
    ps = __uint_as_float(rr[0]) + __uint_as_float(rr[1]); }
  l_reg = l_reg * alpha + ps;
#define PK4(P, BASE, OUT) do { unsigned a0 = cvtpk(P[BASE + 0], P[BASE + 1]), a1 = cvtpk(P[BASE + 2], P[BASE + 3]);   \
    unsigned b0 = cvtpk(P[BASE + 4], P[BASE + 5]), b1 = cvtpk(P[BASE + 6], P[BASE + 7]);                              \
    auto r0 = __builtin_amdgcn_permlane32_swap(a0, b0, false, false); auto r1 = __builtin_amdgcn_permlane32_swap(a1, b1, false, false); \
    u32x4 w = {r0[0], r1[0], r0[1], r1[1]}; OUT = *reinterpret_cast<bf16x8*>(&w); } while (0)
  PK4(p0, 0, pa0); PK4(p0, 8, pa1); PK4(p1, 0, pa2); PK4(p1, 8, pa3);
#undef PK4
}
__device__ __forceinline__ void qkt(f32x16& p0, f32x16& p1, const char* Ks, const bf16x8* qr, int r32, int hi) {
#pragma unroll
  for (int r = 0; r < 16; ++r) { p0[r] = 0.f; p1[r] = 0.f; }
  const int sw = (r32 >> 1) & 7; const char* k0p = Ks + r32 * 384; const char* k1p = k0p + 32 * 384;
#pragma unroll
  for (int d0 = 0; d0 < 12; ++d0) { const int off = ((2 * d0 + hi) ^ sw) << 4;
    const bf16x8 b0 = *reinterpret_cast<const bf16x8*>(k0p + off);
    const bf16x8 b1 = *reinterpret_cast<const bf16x8*>(k1p + off);
    p0 = __builtin_amdgcn_mfma_f32_32x32x16_bf16(b0, qr[d0], p0, 0, 0, 0);
    p1 = __builtin_amdgcn_mfma_f32_32x32x16_bf16(b1, qr[d0], p1, 0, 0, 0);
    if ((d0 & 1) == 1) SBAR(); }
}
__device__ __forceinline__ int v_st(int k, int c) { const int kk = (k & ~0xC) | ((k & 4) << 1) | ((k & 8) >> 1); return ((kk >> 3) * 4 + (c >> 5)) * 512 + ((kk & 7) * 32 + (c & 31)) * 2; }
__device__ __forceinline__ int v_rd_base(int lane) { return ((lane & 3) << 3) | (((lane >> 2) & 3) << 6) | (((lane >> 4) & 1) << 5) | (((lane >> 5) & 1) << 8); }
constexpr int v_rd_off(int d0, int ks, int half) { return d0 * 512 + ks * 4096 + half * 2048; }
template <int OFF> __device__ __forceinline__ s16x4 tr_read(int vb) {
  s16x4 r; asm volatile("ds_read_b64_tr_b16 %0, %1 offset:%2" : "=&v"(r) : "v"(vb), "i"(OFF) : "memory"); return r;
}
template <int D0> __device__ __forceinline__ void pv_one(f32x16& od, int vb, bf16x8 pa0, bf16x8 pa1, bf16x8 pa2, bf16x8 pa3) {
  const s16x4 l0 = tr_read<v_rd_off(D0, 0, 0)>(vb), h0 = tr_read<v_rd_off(D0, 0, 1)>(vb), l1 = tr_read<v_rd_off(D0, 1, 0)>(vb), h1 = tr_read<v_rd_off(D0, 1, 1)>(vb);
  const s16x4 l2 = tr_read<v_rd_off(D0, 2, 0)>(vb), h2 = tr_read<v_rd_off(D0, 2, 1)>(vb), l3 = tr_read<v_rd_off(D0, 3, 0)>(vb), h3 = tr_read<v_rd_off(D0, 3, 1)>(vb);
  asm volatile("s_waitcnt lgkmcnt(0)" ::: "memory"); SBAR();
#define PK(L, H) (bf16x8){L[0], L[1], L[2], L[3], H[0], H[1], H[2], H[3]}
  od = __builtin_amdgcn_mfma_f32_32x32x16_bf16(pa0, PK(l0, h0), od, 0, 0, 0);
  od = __builtin_amdgcn_mfma_f32_32x32x16_bf16(pa1, PK(l1, h1), od, 0, 0, 0);
  od = __builtin_amdgcn_mfma_f32_32x32x16_bf16(pa2, PK(l2, h2), od, 0, 0, 0);
  od = __builtin_amdgcn_mfma_f32_32x32x16_bf16(pa3, PK(l3, h3), od, 0, 0, 0);
#undef PK
}
__device__ __forceinline__ void pv_d0(f32x16* o, int vb, bf16x8 pa0, bf16x8 pa1, bf16x8 pa2, bf16x8 pa3) {
  pv_one<0>(o[0], vb, pa0, pa1, pa2, pa3); pv_one<1>(o[1], vb, pa0, pa1, pa2, pa3); pv_one<2>(o[2], vb, pa0, pa1, pa2, pa3); pv_one<3>(o[3], vb, pa0, pa1, pa2, pa3);
}

__device__ __forceinline__ void unit(const bf16_t* __restrict__ Qb, const bf16_t* __restrict__ Kh, const bf16_t* __restrict__ Vh, bf16_t* __restrict__ Ob, const bf16_t* __restrict__ Gb, float* __restrict__ Sb, char* lds, int j0 = 0) {
  const int tid = threadIdx.x, wid = __builtin_amdgcn_readfirstlane(tid >> 6), lane = tid & 63, r32 = lane & 31, hi = lane >> 5;
  char* V_lds = lds; char* K_lds = lds + 2 * SHM_V;
  float* wsf = (float*)(lds + 2 * SHM_V + 2 * SHM_K) + wid * 64; float* li_l = wsf; float* al_l = wsf + 32;
  float m_reg = -1e30f, l_reg = 0; f32x16 o[4]; bf16x8 qr[12];
#pragma unroll
  for (int d = 0; d < 4; ++d)
#pragma unroll
    for (int r = 0; r < 16; ++r) o[d][r] = 0.f;
  const bf16_t* Qw = Qb + (size_t)(wid * QBLK + r32) * DQK + hi * 8;
#pragma unroll
  for (int d0 = 0; d0 < 12; ++d0) qr[d0] = *reinterpret_cast<const bf16x8*>(Qw + d0 * 16);
  unsigned ksrc[3], vsrc[2];
#pragma unroll
  for (int i = 0; i < 3; ++i) { const int s = (i * 8 + wid) * 64 + lane, row = s / 24, cp = s - row * 24, c = (cp & ~7) | ((cp & 7) ^ ((row >> 1) & 7)); ksrc[i] = row * DQK + c * 8; }
#pragma unroll
  for (int i = 0; i < 2; ++i) { const int s = (i * 8 + wid) * 64 + lane, sub = s >> 5, within = s & 31, kk = (sub >> 2) * 8 + (within >> 2);
    const int k = (kk & ~0xC) | ((kk & 4) << 1) | ((kk & 8) >> 1), c = (sub & 3) * 32 + (within & 3) * 8; vsrc[i] = k * DV + c; }
  const unsigned ldsb = (unsigned)(uintptr_t)lds;
  const int vb0 = (int)(uintptr_t)V_lds + v_rd_base(lane);
#define KDMA(b, k0) do { const int k0_ = (k0), b_ = (b); _Pragma("unroll") for (int q_ = 0; q_ < 3; ++q_) dma16(Kh + (size_t)k0_ * DQK + ksrc[q_], __builtin_amdgcn_readfirstlane(ldsb + 2 * SHM_V + b_ * SHM_K + (q_ * 8 + wid) * 1024)); } while (0)
#define VDMA(b, k0) do { const int k0_ = (k0), b_ = (b); _Pragma("unroll") for (int q_ = 0; q_ < 2; ++q_) dma16(Vh + (size_t)k0_ * DV + vsrc[q_], __builtin_amdgcn_readfirstlane(ldsb + b_ * SHM_V + (q_ * 8 + wid) * 1024)); } while (0)
#define VMWAIT(n) asm volatile("s_waitcnt vmcnt(" #n ")" ::: "memory")
#define RESC(a) do { if (__any((a) < 1.f)) { if (hi == 0) al_l[r32] = (a); asm volatile("s_waitcnt lgkmcnt(0)" ::: "memory"); \
    _Pragma("unroll") for (int d = 0; d < 4; ++d) _Pragma("unroll") for (int r = 0; r < 16; ++r) o[d][r] *= al_l[crow(r, hi)]; } } while (0)
  f32x16 p0, p1; float mn, al; bf16x8 pa0, pa1, pa2, pa3; constexpr int NT = SEQ / KVBLK;
  const bool late = (ATT_LATE) && wid >= 4;
#define XPH_A(b) do { SBAR(); __builtin_amdgcn_s_setprio(1); qkt(p0, p1, K_lds + (b) * SHM_K, qr, r32, hi); __builtin_amdgcn_s_setprio(0); SBAR(); } while (0)
#define XPH_B() do { partialSM(p0, p1, m_reg, mn, al); SBAR(); } while (0)
#define YPH(b) do { SBAR(); RESC(al); finishSM(p0, p1, al, l_reg, pa0, pa1, pa2, pa3); SBAR(); __builtin_amdgcn_s_setprio(2); pv_d0(o, vb0 + (b) * SHM_V, pa0, pa1, pa2, pa3); __builtin_amdgcn_s_setprio(0); SBAR(); } while (0)
#define TILE(t) ((((t) + j0) & (NT - 1)) * KVBLK)
  KDMA(0, TILE(0)); VDMA(0, TILE(0));
#pragma unroll
  for (int d0 = 0; d0 < 12; ++d0) asm volatile("" : "+v"(qr[d0]));
  VMWAIT(0); __syncthreads();
  if (late) { KDMA(1, TILE(1)); VMWAIT(3); __syncthreads(); }
#pragma unroll 1
  for (int i = 0; i < NT; ++i) {
    const int buf = i & 1;
    XPH_A(buf);
    if (!late) { if (i + 1 < NT) { KDMA(buf ^ 1, TILE(i + 1)); } } else { if (i + 1 < NT) { VDMA(buf ^ 1, TILE(i + 1)); } }
    XPH_B();
    if (i + 1 < NT) { if (!late) VMWAIT(3); else VMWAIT(2); } else VMWAIT(0);
    __syncthreads();
    if (!late) { if (i + 1 < NT) { VDMA(buf ^ 1, TILE(i + 1)); } } else { if (i + 2 < NT) { KDMA(buf, TILE(i + 2)); } }
    YPH(buf);
    if (!late) { if (i + 1 < NT) VMWAIT(2); else VMWAIT(0); } else { if (i + 2 < NT) VMWAIT(3); else VMWAIT(0); }
    __syncthreads();
  }
  if (!late) __syncthreads();
#undef XPH_A
#undef XPH_B
#undef YPH
#undef TILE
  if (hi == 0) li_l[r32] = l_reg; asm volatile("s_waitcnt lgkmcnt(0)" ::: "memory");
  float rli[16];
#pragma unroll
  for (int r = 0; r < 16; ++r) rli[r] = __builtin_amdgcn_rcpf(li_l[crow(r, hi)]);
  char* ow = lds + wid * 8192;
  {
    const int r32e = opaque(r32);
    const bool odd = r32e & 1;
#pragma unroll
    for (int r = 0; r < 16; r += 2) {
      const int orow = crow(r, hi) + (odd ? 1 : 0);
#pragma unroll
      for (int d0 = 0; d0 < 4; ++d0) {
        const float a = o[d0][r] * rli[r], b = o[d0][r + 1] * rli[r + 1];
        const float x = __shfl_xor(odd ? a : b, 1);
        const unsigned w = odd ? pack2(x, b) : pack2(a, x);
        const int col = d0 * 32 + (r32e & ~1);
        *(unsigned*)(ow + orow * 256 + ((((col >> 3) ^ orow) & 15) << 4) + ((col & 7) << 1)) = w;
      }
    }
  }
  asm volatile("s_waitcnt lgkmcnt(0)" ::: "memory");
  {
    const int le = opaque(lane), chunk = le & 15, rsub = le >> 4;
    bf16_t* Ow = Ob + (size_t)(wid * QBLK) * 1024 + chunk * 8; const bf16_t* Gw = Gb + (size_t)(wid * QBLK) * AW + chunk * 8; float* Sw = Sb + (size_t)(wid * QBLK) * 4;
    u32x4 gv[8];
#pragma unroll
    for (int i = 0; i < 8; ++i) gv[i] = *(const u32x4*)(Gw + (size_t)(4 * i + rsub) * AW);
#pragma unroll
    for (int i = 0; i < 8; ++i) {
      const int row = 4 * i + rsub;
      const u32x4 ov = *(const u32x4*)(ow + row * 256 + (((chunk ^ row) & 15) << 4));
      float s = 0.f; u32x4 wv;
#pragma unroll
      for (int e = 0; e < 4; ++e) {
        const float o0 = __uint_as_float(ov[e] << 16), o1 = __uint_as_float(ov[e] & 0xffff0000u);
        s += o0 * o0 + o1 * o1;
        wv[e] = pack2(o0 * __uint_as_float(gv[i][e] << 16), o1 * __uint_as_float(gv[i][e] & 0xffff0000u));
      }
      *(u32x4*)(Ow + (size_t)row * 1024) = wv;
      s += __shfl_xor(s, 1); s += __shfl_xor(s, 2); s += __shfl_xor(s, 4); s += __shfl_xor(s, 8);
      if (chunk == 0) Sw[row * 4] = s;
    }
  }
  __syncthreads();
#undef KDMA
#undef VDMA
#undef VMWAIT
#undef RESC
}
}

__device__ __forceinline__ void attn_unit(const Params& p, int u, char* lds) {
  const int qb = u & 7, bh = u >> 3;
  const bf16_t* Q = (const bf16_t*)(p.ws + WS_Q); const bf16_t* Kf = (const bf16_t*)(p.ws + WS_K); const bf16_t* V = (const bf16_t*)(p.ws + WS_V); const bf16_t* gat = (const bf16_t*)(p.ws + WS_GAT); float* ssa = (float*)(p.ws + WS_SSA);
  const int b = bh >> 2, h = bh & 3;
  att::unit(Q + ((size_t)bh * SEQ + qb * 256) * DQK, Kf + (size_t)bh * SEQ * DQK, V + (size_t)bh * SEQ * DV, amix_tile(p.ws, b * 8 + qb) + h * DV, gat + ((size_t)b * SEQ + qb * 256) * AW + h * DV, ssa + ((size_t)b * SEQ + qb * 256) * 4 + h, lds, ATT_ROT * qb);
}
__device__ void s5_unit(const Params& p, int unit, char* lds, char* scr) {
  GemmRegs G;
  const int g = unit & 31, j = unit >> 5;
  const int tid = threadIdx.x, lane = tid & 63, w = tid >> 6, wm = w >> 2, wn = w & 3;
  const bf16_t* U = (const bf16_t*)(p.ws + WS_US) + ((size_t)g * NTOK + (size_t)j * 4096) * 16;
  bf16_t* carry = (bf16_t*)scr;
  f32x16 acc[2][4];
  const bf16_t* mq = (const bf16_t*)(p.ws + WS_S5MQ) + (size_t)g * 131072;
  gemm256(U, 256, 16, 64, 4, U, 256, 16, 64, 0, (const bf16_t*)(p.ws + WS_S5P) + (size_t)g * 65536, 256, 64, lds, acc, G, false);
  {
    const int lane_o = opaque(lane), l31 = lane_o & 31, hi = lane_o >> 5;
#pragma unroll
    for (int mt = 0; mt < 4; ++mt) {
      const int r = 128 * wm + 32 * mt + l31;
#pragma unroll
      for (int nt = 0; nt < 2; ++nt)
#pragma unroll
        for (int q = 0; q < 4; ++q)
          tile_put(lds, r, 64 * wn + 32 * nt + 8 * q + 4 * hi, pack2(acc[nt][mt][4 * q], acc[nt][mt][4 * q + 1]), pack2(acc[nt][mt][4 * q + 2], acc[nt][mt][4 * q + 3]));
      __builtin_amdgcn_sched_barrier(0);
    }
  }
  gemm_preload(GNext{U, 256, 16, 64, mq, 512, 64, 0, 8}, G);
  __syncthreads();
  if (tid < 256) {
    const int bb = tid >> 7, idx = tid & 127, dir = idx >> 6, n = 2 * idx;
    const f32x2 lt = ((const f32x2*)(p.ws + WS_S5LT))[g * 128 + idx];
    float hr = 0.f, hi_ = 0.f;
#pragma unroll 8
    for (int cc = 0; cc < 128; ++cc) {
      const int c = dir ? 127 - cc : cc, r = bb * 128 + c;
      const unsigned sv = *(const unsigned*)(lds + r * 512 + ((((n >> 3) ^ r) & 31) << 4) + ((n & 7) << 1));
      *(unsigned*)(carry + (size_t)r * 256 + n) = pack2(hr, hi_);
      const float sr = __uint_as_float(sv << 16), si = __uint_as_float(sv & 0xffff0000u);
      const float nr = lt[0] * hr - lt[1] * hi_ + sr, ni = lt[0] * hi_ + lt[1] * hr + si;
      hr = nr; hi_ = ni;
    }
  }
  __syncthreads();
  gemm256(U, 256, 16, 64, 4, carry, 256, 16, 64, 4, mq, 512, 64, lds, acc, G, true);
  {
    const int lane_o = opaque(lane), l31 = lane_o & 31, hi = lane_o >> 5;
#pragma unroll
    for (int mt = 0; mt < 4; ++mt) {
      const int r = 128 * wm + 32 * mt + l31;
#pragma unroll
      for (int nt = 0; nt < 2; ++nt)
#pragma unroll
        for (int q = 0; q < 4; ++q) {
          const int n = 64 * wn + 32 * nt + 8 * q + 4 * hi;
          const u32x2 uv = *(const u32x2*)(U + (size_t)r * 256 + n);
          const f32x4 dv = *(const f32x4*)(p.s5d + g * 16 + (n & 15));
          const float u[4] = {__uint_as_float(uv[0] << 16), __uint_as_float(uv[0] & 0xffff0000u), __uint_as_float(uv[1] << 16), __uint_as_float(uv[1] & 0xffff0000u)};
          float y[4];
#pragma unroll
          for (int e = 0; e < 4; ++e) y[e] = gelu_tanh_f(acc[nt][mt][4 * q + e] + dv[e] * u[e]);
          tile_put(lds, r, n, pack2(y[0], y[1]), pack2(y[2], y[3]));
        }
      __builtin_amdgcn_sched_barrier(0);
    }
  }
  __syncthreads();
  tile_out(lds, (bf16_t*)(p.ws + WS_YS) + ((size_t)g * NTOK + (size_t)j * 4096) * 16 + (opaque(tid) & 31) * 8, 256, 1, 0);
  __syncthreads();
}
namespace cg = cooperative_groups;

constexpr int LDS_BYTES = GEMM_LDS + 16384;

__device__ __forceinline__ void group_barrier(unsigned* cnt, unsigned target) {
  asm volatile("s_waitcnt vmcnt(0)" ::: "memory");
  __syncthreads();
  if (threadIdx.x == 0) {
    __builtin_amdgcn_fence(__ATOMIC_RELEASE, "agent");
    __hip_atomic_fetch_add(cnt, 1u, __ATOMIC_RELAXED, __HIP_MEMORY_SCOPE_AGENT);
    while (__hip_atomic_load(cnt, __ATOMIC_RELAXED, __HIP_MEMORY_SCOPE_AGENT) < target) __builtin_amdgcn_s_sleep(4);
    __builtin_amdgcn_fence(__ATOMIC_ACQUIRE, "agent");
  }
  __syncthreads();
}

__global__ __launch_bounds__(512, 1) void hymba_megakernel(Params p) {
  extern __shared__ __attribute__((aligned(16))) char lds[];
  cg::grid_group grid = cg::this_grid();
  const int nblk = gridDim.x, bid = blockIdx.x;
  const bool xloc = (nblk == 256);
  unsigned* gcnt = (unsigned*)(p.ws + WS_BAR) + (bid & 7) * 64;
  if (bid == 0 && threadIdx.x < 8) ((unsigned*)(p.ws + WS_BAR))[threadIdx.x * 64] = 0u;
  prep_phase(p, bid, nblk, (float*)lds);
  grid.sync();
  {
    const bool g256 = (nblk == 256);
    const int x = bid & 7, c = bid >> 3, mrow = c >> 3, nc0 = c & 7;
    const int iters = g256 ? 8 : 8 * ((NTOK / 256 - bid + nblk - 1) / nblk);
#pragma unroll 1
    for (int it = 0; it < iters; ++it) {
      const int j8 = (nc0 + it) & 7;
      const int nt = g256 ? (((j8 & 3) << 1) | (j8 >> 2)) : (it & 7), mt_ = g256 ? 32 * x + 4 * it + mrow : bid + (it >> 3) * nblk;
      const int up = g256 ? (nt < 2 ? nt + 1 : 0) : (nt == 7 ? 3 : 0);
      phase1_win(p, mt_, nt, lds, 0);
      if (up) phase1_up(p, mt_, up, lds, g256);
    }
  }
  if (xloc) group_barrier(gcnt, 32u); else grid.sync();
  {
    const int x = bid & 7, c = bid >> 3;
    char* scr = p.ws + WS_SCR + (size_t)bid * 393216;
    const bool g256 = (nblk == 256);
    const int n5 = g256 ? 2 : (512 - bid + nblk - 1) / nblk, na = g256 ? 4 : (NB * NH * 8 - bid + nblk - 1) / nblk;
    const bool s5first = ((bid >> 6) & 1) == 0;
    if (s5first) {
#pragma unroll 1
      for (int r = 0; r < n5; ++r) s5_unit(p, g256 ? c + 32 * (2 * x + r) : bid + r * nblk, lds, scr);
    }
#pragma unroll 1
      for (int r = 0; r < na; ++r) attn_unit(p, g256 ? ((((4 * x + (3 - r)) * 4 + (c >> 3))) << 3) + (c & 7) : bid + r * nblk, lds);
    if (!s5first) {
#pragma unroll 1
      for (int r = 0; r < n5; ++r) s5_unit(p, g256 ? c + 32 * (2 * x + r) : bid + r * nblk, lds, scr);
    }
  }
  if (xloc) group_barrier(gcnt, 64u); else grid.sync();
  for (int t = bid; t < NTOK / 256; t += nblk) phase3_tile(p, (nblk == 256) ? 32 * (bid & 7) + (bid >> 3) : t, lds);
}

static Params make_params(void* const* d_in, void* d_out, void* d_ws) {
  Params p{};
  p.x = (const float*)d_in[0]; p.pos = (const int*)d_in[1]; p.pre_g = (const float*)d_in[2]; p.w_in = (const float*)d_in[3]; p.q_g = (const float*)d_in[4];
  p.w_uq = (const float*)d_in[5]; p.kv_g = (const float*)d_in[6]; p.w_ukv = (const float*)d_in[7]; p.ao_g = (const float*)d_in[8]; p.lam_re = (const float*)d_in[9];
  p.lam_im = (const float*)d_in[10]; p.log_dt = (const float*)d_in[11]; p.b_re = (const float*)d_in[12]; p.b_im = (const float*)d_in[13]; p.c_re = (const float*)d_in[14];
  p.c_im = (const float*)d_in[15]; p.s5d = (const float*)d_in[16]; p.w_glu = (const float*)d_in[17]; p.b_glu = (const float*)d_in[18]; p.so_g = (const float*)d_in[19];
  p.w_out = (const float*)d_in[20]; p.post_g = (const float*)d_in[21]; p.out = (float*)d_out; p.ws = (char*)d_ws;
  return p;
}

extern "C" void kernel_launch(void* const* d_in, const int* in_sizes, int n_in, void* d_out, int out_size, void* d_ws, size_t ws_size, hipStream_t stream) {
  if (n_in != 22 || in_sizes[0] != NTOK * DM || out_size != NTOK * DM || ws_size < WS_END) {
    fprintf(stderr, "kernel_launch: shape mismatch n_in %d in0 %d out %d ws %zu (need %zu)\n", n_in, n_in > 0 ? in_sizes[0] : -1, out_size, ws_size, (size_t)WS_END);
    return;
  }
  static int grid_blocks = 0;
  if (!grid_blocks) {
    if (hipFuncSetAttribute((const void*)hymba_megakernel, hipFuncAttributeMaxDynamicSharedMemorySize, LDS_BYTES) != hipSuccess) { fprintf(stderr, "kernel_launch: LDS attribute failed\n"); return; }
    int dev = 0, cus = 0, per_cu = 0;
    (void)hipGetDevice(&dev);
    (void)hipDeviceGetAttribute(&cus, hipDeviceAttributeMultiprocessorCount, dev);
    (void)hipOccupancyMaxActiveBlocksPerMultiprocessor(&per_cu, hymba_megakernel, 512, LDS_BYTES);
    if (per_cu < 1 || cus < 1) { fprintf(stderr, "kernel_launch: occupancy query gave %d blocks/CU on %d CUs\n", per_cu, cus); return; }
    grid_blocks = cus;
  }
  Params p = make_params(d_in, d_out, d_ws);
  void* args[] = {&p};
  hipError_t e = hipLaunchCooperativeKernel((void*)hymba_megakernel, dim3(grid_blocks), dim3(512), args, LDS_BYTES, stream);
  if (e != hipSuccess) fprintf(stderr, "cooperative launch failed: %s (grid %d)\n", hipGetErrorString(e), grid_blocks);
}
```
